# Optimizing an MI355X kernel written in HIP

```python
import math
import jax, jax.numpy as jnp
from jax import lax
import numpy as np

D_MODEL = 4096
BATCH = 4
SEQ = 2048
DEPTH = 1
DEC_BATCH = 1
DEC_SEQ = 16384
PAST_LEN = 128

GRID_W = 64
NA_HEADS = 16
NA_HEAD_DIM = 128
NA_WIDTH = NA_HEADS * NA_HEAD_DIM
NA_KH = 8
NA_KW = 16
NA_COL_BLOCK = 16
NA_KEY_BLOCK = NA_COL_BLOCK + NA_KW
MLA_HEADS = 16
Q_LORA = 896
KV_LORA = 512
QK_NOPE = 128
QK_ROPE = 64
V_HEAD = 128
ROPE_THETA = 10000.0
Q_BLOCK = 128
D_FF = 11008
CONV_W = 3
NORM_EPS = 1e-6
N_MOD = 6
IN_SIZES = (NA_WIDTH, NA_WIDTH, NA_WIDTH, Q_LORA, KV_LORA, QK_ROPE, D_MODEL, D_MODEL)
IN_WIDTH = 3 * NA_WIDTH + Q_LORA + KV_LORA + QK_ROPE + 2 * D_MODEL

kernel_name = 'hybrid_na_mla_convglu_encoder'


def _rms_norm(x, g):
    xf = x.astype(jnp.float32)
    y = xf * lax.rsqrt(jnp.mean(xf * xf, axis=-1, keepdims=True) + NORM_EPS)
    return (y * g.astype(jnp.float32)).astype(x.dtype)


def _rope_tables(L, dtype):
    inv = jnp.power(ROPE_THETA, -jnp.arange(0, QK_ROPE, 2, dtype=jnp.float32) / QK_ROPE)
    ang = jnp.arange(L, dtype=jnp.float32)[:, None] * inv[None, :]
    return jnp.cos(ang).astype(dtype), jnp.sin(ang).astype(dtype)


def _rope(x, cos, sin):
    half = QK_ROPE // 2
    x1, x2 = x[..., :half], x[..., half:]
    return jnp.concatenate([x1 * cos - x2 * sin, x1 * sin + x2 * cos], axis=-1)


def _neighborhood_attention(q, k, v, rpb):
    b, L, h, d = q.shape
    rows = L // GRID_W
    kh = min(NA_KH, rows)
    n_cb = GRID_W // NA_COL_BLOCK
    qcol = np.arange(GRID_W).reshape(n_cb, NA_COL_BLOCK)
    kstart = np.clip(np.arange(n_cb) * NA_COL_BLOCK - NA_KW // 2, 0, GRID_W - NA_KEY_BLOCK)
    kcol = kstart[:, None] + np.arange(NA_KEY_BLOCK)[None, :]
    cstart = np.clip(qcol - NA_KW // 2, 0, GRID_W - NA_KW)
    dc = kcol[:, None, :] - qcol[:, :, None]
    col_valid = (kcol[:, None, :] >= cstart[:, :, None]) & (kcol[:, None, :] < cstart[:, :, None] + NA_KW)
    dc_idx = np.clip(dc + NA_KW - 1, 0, 2 * NA_KW - 2)
    mask = jnp.asarray(col_valid)[:, :, None, :]
    qg = jnp.moveaxis(q.reshape(b, rows, n_cb, NA_COL_BLOCK, h, d), 1, 0)
    kcb = k.reshape(b, rows, GRID_W, h, d)[:, :, kcol]
    vcb = v.reshape(b, rows, GRID_W, h, d)[:, :, kcol]
    scale = d ** -0.5

    def row_fn(args):
        q_row, r = args
        start = jnp.clip(r - kh // 2, 0, rows - kh)
        k_row = lax.dynamic_slice_in_dim(kcb, start, kh, axis=1)
        v_row = lax.dynamic_slice_in_dim(vcb, start, kh, axis=1)
        s = jnp.einsum('bnqhd,bknjhd->bhnqkj', q_row, k_row).astype(jnp.float32) * scale
        dr_idx = start + jnp.arange(kh) - r + NA_KH - 1
        bias = rpb[:, dr_idx][:, :, dc_idx]
        s = s + jnp.transpose(bias, (0, 2, 3, 1, 4)).astype(jnp.float32)
        s = jnp.where(mask, s, jnp.float32(-1e30))
        p = jax.nn.softmax(s.reshape(s.shape[:4] + (kh * NA_KEY_BLOCK,)), axis=-1).reshape(s.shape)
        return jnp.einsum('bhnqkj,bknjhd->bnqhd', p.astype(v_row.dtype), v_row)

    out = lax.map(row_fn, (qg, jnp.arange(rows)))
    return jnp.moveaxis(out, 0, 1).reshape(b, L, h * d)


def _mla(q_down, kv_down, k_rope, g_q, w_uq, g_kv, w_ukv):
    b, L, _ = q_down.shape
    q = (_rms_norm(q_down, g_q) @ w_uq).reshape(b, L, MLA_HEADS, QK_NOPE + QK_ROPE)
    kv = (_rms_norm(kv_down, g_kv) @ w_ukv).reshape(b, L, MLA_HEADS, QK_NOPE + V_HEAD)
    q_nope, q_pe = q[..., :QK_NOPE], q[..., QK_NOPE:]
    k_nope, v = kv[..., :QK_NOPE], kv[..., QK_NOPE:]
    cos, sin = _rope_tables(L, q.dtype)
    q_pe = _rope(q_pe, cos[:, None, :], sin[:, None, :])
    k_pe = _rope(k_rope, cos, sin)
    scale = (QK_NOPE + QK_ROPE) ** -0.5
    nq = L // Q_BLOCK
    qn = jnp.moveaxis(q_nope.reshape(b, nq, Q_BLOCK, MLA_HEADS, QK_NOPE), 1, 0)
    qp = jnp.moveaxis(q_pe.reshape(b, nq, Q_BLOCK, MLA_HEADS, QK_ROPE), 1, 0)

    def block_fn(args):
        qn_b, qp_b = args
        s = (jnp.einsum('bqhd,bkhd->bhqk', qn_b, k_nope)
             + jnp.einsum('bqhr,bkr->bhqk', qp_b, k_pe)).astype(jnp.float32) * scale
        p = jax.nn.softmax(s, axis=-1)
        return jnp.einsum('bhqk,bkhd->bqhd', p.astype(v.dtype), v)

    out = lax.map(block_fn, (qn, qp))
    return jnp.moveaxis(out, 0, 1).reshape(b, L, MLA_HEADS * V_HEAD)


def _layer(x, c, w_ada, b_ada, g_pre_mix, g_post_mix, w_in, rpb, g_q, w_uq, g_kv, w_ukv,
           w_na_proj, w_mla_proj, w_out, g_pre_ffn, g_post_ffn, w_ffn_in, conv_w, conv_b, w_ffn_down):
    b, L, _ = x.shape
    mod = jax.nn.silu(c) @ w_ada + b_ada
    shift1, scale1, gate1, shift2, scale2, gate2 = jnp.split(mod[:, None, :], N_MOD, axis=-1)
    h = _rms_norm(x, g_pre_mix) * (1.0 + scale1) + shift1
    z = h @ w_in
    cuts = [int(s) for s in np.cumsum(IN_SIZES)[:-1]]
    q_na, k_na, v_na, q_down, kv_down, k_rope, gate_na, gate_mla = jnp.split(z, cuts, axis=-1)
    hs = (b, L, NA_HEADS, NA_HEAD_DIM)
    o_na = _neighborhood_attention(q_na.reshape(hs), k_na.reshape(hs), v_na.reshape(hs), rpb)
    o_mla = _mla(q_down, kv_down, k_rope, g_q, w_uq, g_kv, w_ukv)
    merged = jax.nn.sigmoid(gate_na) * (o_na @ w_na_proj) + jax.nn.sigmoid(gate_mla) * (o_mla @ w_mla_proj)
    x = x + gate1 * _rms_norm(merged @ w_out, g_post_mix)
    h = _rms_norm(x, g_pre_ffn) * (1.0 + scale2) + shift2
    a, u = jnp.split(h @ w_ffn_in, 2, axis=-1)
    ap = jnp.pad(a, ((0, 0), (1, 1), (0, 0)))
    a = ap[:, :-2] * conv_w[0] + ap[:, 1:-1] * conv_w[1] + ap[:, 2:] * conv_w[2] + conv_b
    f = (jax.nn.gelu(a) * u) @ w_ffn_down
    return x + gate2 * _rms_norm(f, g_post_ffn)


def setup_inputs(seed: int = 0) -> dict:
    key = jax.random.key(seed)
    ks = jax.random.split(key, 24)

    def nrm(k, shape, scale):
        return jax.random.normal(k, shape, jnp.float32) * scale

    def gain(k, shape):
        return 1.0 + 0.05 * jax.random.normal(k, shape, jnp.float32)

    D = D_MODEL
    return {
        'x_prompt': nrm(ks[0], (BATCH, SEQ, D), 1.0),
        'x_sample': nrm(ks[1], (DEC_BATCH, DEC_SEQ, D), 1.0),
        'c_prompt': nrm(ks[2], (BATCH, D), 1.0),
        'c_sample': nrm(ks[3], (DEC_BATCH, D), 1.0),
        'w_ada': nrm(ks[4], (DEPTH, D, N_MOD * D), 0.5 * D ** -0.5),
        'b_ada': nrm(ks[5], (DEPTH, N_MOD * D), 0.02),
        'g_pre_mix': gain(ks[6], (DEPTH, D)),
        'g_post_mix': gain(ks[7], (DEPTH, D)),
        'w_in': nrm(ks[8], (DEPTH, D, IN_WIDTH), D ** -0.5),
        'rpb': nrm(ks[9], (DEPTH, NA_HEADS, 2 * NA_KH - 1, 2 * NA_KW - 1), 0.1),
        'g_q': gain(ks[10], (DEPTH, Q_LORA)),
        'w_uq': nrm(ks[11], (DEPTH, Q_LORA, MLA_HEADS * (QK_NOPE + QK_ROPE)), Q_LORA ** -0.5),
        'g_kv': gain(ks[12], (DEPTH, KV_LORA)),
        'w_ukv': nrm(ks[13], (DEPTH, KV_LORA, MLA_HEADS * (QK_NOPE + V_HEAD)), KV_LORA ** -0.5),
        'w_na_proj': nrm(ks[14], (DEPTH, NA_WIDTH, D), NA_WIDTH ** -0.5),
        'w_mla_proj': nrm(ks[15], (DEPTH, MLA_HEADS * V_HEAD, D), (MLA_HEADS * V_HEAD) ** -0.5),
        'w_out': nrm(ks[16], (DEPTH, D, D), D ** -0.5),
        'g_pre_ffn': gain(ks[17], (DEPTH, D)),
        'g_post_ffn': gain(ks[18], (DEPTH, D)),
        'w_ffn_in': nrm(ks[19], (DEPTH, D, 2 * D_FF), D ** -0.5),
        'conv_w': nrm(ks[20], (DEPTH, CONV_W, D_FF), CONV_W ** -0.5),
        'conv_b': nrm(ks[21], (DEPTH, D_FF), 0.01),
        'w_ffn_down': nrm(ks[22], (DEPTH, D_FF, D), D_FF ** -0.5),
    }


def reference(x_prompt, x_sample, c_prompt, c_sample, w_ada, b_ada, g_pre_mix, g_post_mix, w_in, rpb,
              g_q, w_uq, g_kv, w_ukv, w_na_proj, w_mla_proj, w_out, g_pre_ffn, g_post_ffn,
              w_ffn_in, conv_w, conv_b, w_ffn_down):
    y_prompt = x_prompt
    y_sample = x_sample
    for l in range(DEPTH):
        params = (w_ada[l], b_ada[l], g_pre_mix[l], g_post_mix[l], w_in[l], rpb[l], g_q[l], w_uq[l],
                  g_kv[l], w_ukv[l], w_na_proj[l], w_mla_proj[l], w_out[l], g_pre_ffn[l], g_post_ffn[l],
                  w_ffn_in[l], conv_w[l], conv_b[l], w_ffn_down[l])
        y_prompt = _layer(y_prompt, c_prompt, *params)
        y_sample = _layer(y_sample, c_sample, *params)
    return (y_prompt, y_sample)
```

```cpp
#include <hip/hip_runtime.h>
#include <cstdio>
#include <cstdint>

#ifndef MK_N_LAUNCHES
#define MK_N_LAUNCHES 1
#endif

#define LAS __attribute__((address_space(3)))
#define GAS __attribute__((address_space(1)))
typedef unsigned short bf16_t;
typedef short bf16x8 __attribute__((ext_vector_type(8)));
typedef short s16x4 __attribute__((ext_vector_type(4)));
typedef float f32x4 __attribute__((ext_vector_type(4)));
typedef float f32x2 __attribute__((ext_vector_type(2)));
typedef float f32x16 __attribute__((ext_vector_type(16)));
typedef unsigned u32x4 __attribute__((ext_vector_type(4)));
typedef unsigned u32x2 __attribute__((ext_vector_type(2)));

constexpr int DM = 4096, MTOK = 24576, MP = 8192, LP = 2048, LS = 16384;
constexpr int NH = 16, HD = 128, NAW = 2048;
constexpr int QLORA = 896, KVLORA = 512, ROPE = 64, DQK = 192;
constexpr int DFF = 11008, NMOD = 6 * DM;
constexpr int INW = 15808;
constexpr int ZN1 = 13824;
constexpr float EPS = 1e-6f;
constexpr float LOG2E = 1.4426950408889634f;

constexpr size_t MiB = 1u << 20;
constexpr size_t WS_CTL = 0, CTL_ZERO_BYTES = 1 * MiB;
constexpr size_t WS_MOD = 1 * MiB;
constexpr size_t WS_RSQ = 1 * MiB + 512 * 1024;
constexpr size_t WS_RSKV = WS_RSQ + 128 * 1024;
constexpr size_t WS_TBLC = 2 * MiB, WS_TBLS = 4 * MiB;
constexpr size_t WS_KPE = 6 * MiB;
constexpr size_t WS_BFFN = 10 * MiB;
constexpr size_t WS_BDOWN = 182 * MiB;
constexpr size_t WS_H = 268 * MiB;
constexpr size_t WS_ONA = WS_H, WS_OMLA = WS_H + 96 * MiB;
constexpr size_t WS_BIG = 460 * MiB;
constexpr size_t WS_BIN = WS_BIG;
constexpr size_t WS_BUQ = 584 * MiB;
constexpr size_t WS_BUKV = 590 * MiB;
constexpr size_t WS_BNA = 594 * MiB, WS_BMLA = 610 * MiB;
constexpr size_t WS_BOUT = 626 * MiB;
constexpr size_t WS_QNA = 658 * MiB, WS_KNA = 754 * MiB, WS_VT = 850 * MiB;
constexpr size_t WS_QD = 946 * MiB;
constexpr size_t WS_KVD = 994 * MiB;
constexpr size_t WS_QM = 1018 * MiB;
constexpr size_t WS_KNOPE = 1162 * MiB, WS_VM = 1258 * MiB;
constexpr size_t WS_T = WS_QNA;
constexpr size_t WS_Y1 = WS_QM;
constexpr size_t WS_G = WS_BIG;
constexpr size_t WS_SIDE = WS_BIG + 516 * MiB;
constexpr size_t WS_F = WS_H;
constexpr size_t WS_END = 1492 * MiB;
constexpr int CW_TMO = 0, CW_CODE = 1, CW_BAR = 4096;

constexpr int RING_BYTES = 131072;
constexpr int LDSCTL_OFF = 161792, MISC_OFF = LDSCTL_OFF + 320;
constexpr int LDS_BYTES = 163840;
constexpr int NWAVES = 8;

__device__ __forceinline__ unsigned cvt_pk_bf16(float lo, float hi) { unsigned r; asm volatile("v_cvt_pk_bf16_f32 %0, %1, %2" : "=v"(r) : "v"(lo), "v"(hi)); return r; }
__device__ __forceinline__ float bf2f(unsigned short b) { return __uint_as_float(((unsigned)b) << 16); }
__device__ __forceinline__ float bflo(unsigned w) { return __uint_as_float(w << 16); }
__device__ __forceinline__ float bfhi(unsigned w) { return __uint_as_float(w & 0xffff0000u); }
__device__ __forceinline__ float fast_sigmoid(float x) { return __builtin_amdgcn_rcpf(1.0f + __builtin_amdgcn_exp2f(-LOG2E * x)); }
__device__ __forceinline__ int fresh_lane() { unsigned z = 0; asm volatile("" : "+v"(z)); return (int)__builtin_amdgcn_mbcnt_hi(~0u, __builtin_amdgcn_mbcnt_lo(~0u, z)); }
#define LDS_WAIT() asm volatile("s_waitcnt lgkmcnt(0)" ::: "memory")
#define VM_WAIT() asm volatile("s_waitcnt vmcnt(0)" ::: "memory")

namespace pg8 {
constexpr int BM = 256, BK = 64, HALF = 128, HTB = HALF * BK * 2, STAGE_BYTES = 8 * HTB, NXCD = 8, WGM = 8;
__host__ __device__ __forceinline__ int lds_byte(int r, int c) { const int st = (r >> 4) * 2 + (c >> 5), rr = r & 15, cc = c & 31, ob = rr * 64 + cc * 2; return st * 1024 + (ob ^ (((ob >> 9) & 1) << 5)); }
__host__ __device__ __forceinline__ void stage_rc(int b, int& R, int& C) { const int st = b / 1024, sb = b % 1024, swz = sb ^ (((sb >> 9) & 1) << 5); R = (st >> 1) * 16 + swz / 64; C = (st & 1) * 32 + (swz % 64) / 2; }
__host__ __device__ __forceinline__ int perm32(int rho) { const int n = rho >> 4, i = rho & 15; return 8 * (i >> 2) + 4 * n + (i & 3); }

struct Unit { int pm, pn, sub; };
struct Gemm { const bf16_t* A; const bf16_t* Bt; int M, N, K, lda, ldb; const bf16_t* A2; const bf16_t* Bt2; };

struct StaticOrder {
    int nM, nN, nwg, G, c;
    __host__ __device__ void init(int M, int N, int G_, int c_) { nM = M / BM; nN = N / BM; nwg = nM * nN; G = G_; c = c_; }
    __host__ __device__ bool next(int i, Unit& u) const {
        const long L = (long)i * G + c; if (L >= nwg) return false;
        int wgid = (int)L; { const int q = nwg / NXCD, r = nwg % NXCD, xcd = wgid % NXCD, off = wgid / NXCD; wgid = (xcd < r ? xcd * (q + 1) : r * (q + 1) + (xcd - r) * q) + off; }
        const int nig = WGM * nN, gid = wgid / nig, fm = gid * WGM, gsz = (nM - fm) < WGM ? (nM - fm) : WGM;
        u.pm = fm + ((wgid % nig) % gsz); u.pn = (wgid % nig) / gsz; u.sub = 0; return true;
    }
    __device__ __forceinline__ void a_ready(const Unit&) const {}
    __device__ __forceinline__ void done(const Unit&) const {}
};

struct DualOrder : StaticOrder {
    __host__ __device__ bool next(int i, Unit& u) const { const bool ok = StaticOrder::next(i >> 1, u); u.sub = i & 1; return ok; }
};
typedef f32x4 Acc[2][2][4][2];
__device__ __forceinline__ u32x4 pack8(f32x4 v0, f32x4 v1) { u32x4 w; w.x = cvt_pk_bf16(v0[0], v0[1]); w.y = cvt_pk_bf16(v0[2], v0[3]); w.z = cvt_pk_bf16(v1[0], v1[1]); w.w = cvt_pk_bf16(v1[2], v1[3]); return w; }

struct EpiPlain {
    static constexpr bool PERM = true, AFTER_DRAIN = false;
    bf16_t* O; int ldc;
    __device__ __forceinline__ void operator()(const Acc& acc, const Unit& u, int wr, int wc, int fr, int fq) const {
        const int row0 = u.pm * BM + wr * 64 + fr, col0 = u.pn * BM + wc * 32 + 8 * fq;
#pragma unroll
        for (int ai = 0; ai < 2; ++ai)
#pragma unroll
            for (int m = 0; m < 4; ++m) { bf16_t* rowp = O + (size_t)(row0 + ai * HALF + m * 16) * ldc + col0;
#pragma unroll
                for (int bj = 0; bj < 2; ++bj) *(u32x4*)(rowp + bj * HALF) = pack8(acc[ai][bj][m][0], acc[ai][bj][m][1]); }
    }
};
struct EpiZ {
    static constexpr bool PERM = true, AFTER_DRAIN = false;
    bf16_t *qna, *kna, *qd, *kvd, *gna, *gmla;
    __device__ __forceinline__ void operator()(const Acc& acc, const Unit& u, int wr, int wc, int fr, int fq) const {
        const int pn = u.pn; bf16_t* base; int ldc, ct, mode = 0;
        if (pn < 8) { base = qna; ldc = 2048; ct = pn; mode = 1; }
        else if (pn < 16) { base = kna; ldc = 2048; ct = pn - 8; }
        else if (pn < 20) { base = qd; ldc = 1024; ct = pn - 16; }
        else if (pn < 22) { base = kvd; ldc = 512; ct = pn - 20; }
        else if (pn < 38) { base = gna; ldc = 4096; ct = pn - 22; mode = 2; }
        else { base = gmla; ldc = 4096; ct = pn - 38; mode = 2; }
        const int row0 = u.pm * BM + wr * 64 + fr, col0 = ct * BM + wc * 32 + 8 * fq;
        const float qs = 0.08838834764831845f * LOG2E;
#pragma unroll
        for (int ai = 0; ai < 2; ++ai)
#pragma unroll
            for (int m = 0; m < 4; ++m) { bf16_t* rowp = base + (size_t)(row0 + ai * HALF + m * 16) * ldc + col0;
#pragma unroll
                for (int bj = 0; bj < 2; ++bj) { f32x4 v0 = acc[ai][bj][m][0], v1 = acc[ai][bj][m][1];
                    if (mode == 1) { v0 = v0 * qs; v1 = v1 * qs; }
                    if (mode == 2) {
#pragma unroll
                        for (int j = 0; j < 4; ++j) { v0[j] = fast_sigmoid(v0[j]); v1[j] = fast_sigmoid(v1[j]); } }
                    *(u32x4*)(rowp + bj * HALF) = pack8(v0, v1); } }
    }
};
struct EpiUQ {
    static constexpr bool PERM = true, AFTER_DRAIN = false;
    bf16_t* qm; const float* rs;
    __device__ __forceinline__ void operator()(const Acc& acc, const Unit& u, int wr, int wc, int fr, int fq) const {
        const int row0 = u.pm * BM + wr * 64 + fr, col0 = u.pn * BM + wc * 32 + 8 * fq;
#pragma unroll
        for (int ai = 0; ai < 2; ++ai)
#pragma unroll
            for (int m = 0; m < 4; ++m) { const int row = row0 + ai * HALF + m * 16; const float s = rs[row]; bf16_t* rowp = qm + (size_t)row * 3072 + col0;
#pragma unroll
                for (int bj = 0; bj < 2; ++bj) *(u32x4*)(rowp + bj * HALF) = pack8(acc[ai][bj][m][0] * s, acc[ai][bj][m][1] * s); }
    }
};
struct EpiUKV {
    static constexpr bool PERM = true, AFTER_DRAIN = false;
    bf16_t *kn, *vm; const float* rs;
    __device__ __forceinline__ void operator()(const Acc& acc, const Unit& u, int wr, int wc, int fr, int fq) const {
        const int row0 = u.pm * BM + wr * 64 + fr, col0 = u.pn * HD + wc * 32 + 8 * fq;
#pragma unroll
        for (int ai = 0; ai < 2; ++ai)
#pragma unroll
            for (int m = 0; m < 4; ++m) { const int row = row0 + ai * HALF + m * 16; const float s = rs[row];
                *(u32x4*)(kn + (size_t)row * 2048 + col0) = pack8(acc[ai][0][m][0] * s, acc[ai][0][m][1] * s);
                *(u32x4*)(vm + (size_t)row * 2048 + col0) = pack8(acc[ai][1][m][0] * s, acc[ai][1][m][1] * s); }
    }
};
struct EpiMergeDual {
    static constexpr bool PERM = true, AFTER_DRAIN = false;
    bf16_t* T; const bf16_t* gna; const bf16_t* gmla;
    __device__ __forceinline__ void operator()(Acc& acc, const Unit& u, int wr, int wc, int fr, int fq) const {
        const int row0 = u.pm * BM + wr * 64 + fr, col0 = u.pn * BM + wc * 32 + 8 * fq; const float GMIN = 5.9604645e-8f;
#pragma unroll
        for (int ai = 0; ai < 2; ++ai)
#pragma unroll
            for (int m = 0; m < 4; ++m) { const size_t off = (size_t)(row0 + ai * HALF + m * 16) * 4096 + col0;
#pragma unroll
                for (int bj = 0; bj < 2; ++bj) { const u32x4 gm = *(const u32x4*)(gmla + off + bj * HALF);
                    float gmf[8] = {bflo(gm.x), bfhi(gm.x), bflo(gm.y), bfhi(gm.y), bflo(gm.z), bfhi(gm.z), bflo(gm.w), bfhi(gm.w)};
#pragma unroll
                    for (int e = 0; e < 8; ++e) gmf[e] = fmaxf(gmf[e], GMIN);
                    if (u.sub == 0) { const u32x4 gn = *(const u32x4*)(gna + off + bj * HALF);
                        const float gnf[8] = {bflo(gn.x), bfhi(gn.x), bflo(gn.y), bfhi(gn.y), bflo(gn.z), bfhi(gn.z), bflo(gn.w), bfhi(gn.w)};
#pragma unroll
                        for (int e = 0; e < 4; ++e) { acc[ai][bj][m][0][e] *= gnf[e] * __builtin_amdgcn_rcpf(gmf[e]); acc[ai][bj][m][1][e] *= gnf[4 + e] * __builtin_amdgcn_rcpf(gmf[4 + e]); } }
                    else { f32x4 v0 = acc[ai][bj][m][0], v1 = acc[ai][bj][m][1];
#pragma unroll
                        for (int e = 0; e < 4; ++e) { v0[e] *= gmf[e]; v1[e] *= gmf[4 + e]; }
                        *(u32x4*)(T + off + bj * HALF) = pack8(v0, v1); } } }
    }
};
__device__ __forceinline__ float gelu_tanh_f(float x) { const float z = 0.7978845608028654f * (x + 0.044715f * x * x * x); return x * fast_sigmoid(2.0f * z); }
constexpr int SIDE_N = 96 * DFF;
struct EpiFFNConv {
    static constexpr bool PERM = true, AFTER_DRAIN = false;
    bf16_t* G; float* side; const float* cw; const float* cb; LAS float* xch;
    __device__ __forceinline__ void operator()(const Acc& acc, const Unit& u, int wr, int wc, int fr, int fq) const {
        const int lane = fq * 16 + fr, cl0 = wc * 32 + 8 * fq, f0 = u.pn * 128 + cl0;
        LAS float* xf = xch; LAS float* xl = xch + 512;
#pragma unroll
        for (int ai = 0; ai < 2; ++ai) { const int blk = 2 * ai + wr;
#pragma unroll
            for (int n = 0; n < 2; ++n) { if (fr == 0) *(LAS f32x4*)(xf + blk * 128 + cl0 + 4 * n) = acc[ai][0][0][n]; if (fr == 15) *(LAS f32x4*)(xl + blk * 128 + cl0 + 4 * n) = acc[ai][0][3][n]; } }
        asm volatile("s_waitcnt lgkmcnt(0)" ::: "memory"); __builtin_amdgcn_s_barrier(); asm volatile("" ::: "memory");
        const int src_up = (lane & 48) | ((lane + 15) & 15), src_dn = (lane & 48) | ((lane + 1) & 15);
#define SHF4(dst, v, srcl) do { dst[0] = __shfl(v[0], srcl); dst[1] = __shfl(v[1], srcl); dst[2] = __shfl(v[2], srcl); dst[3] = __shfl(v[3], srcl); } while (0)
#pragma unroll
        for (int n = 0; n < 2; ++n) {
            const f32x4 w0 = *(const f32x4*)(cw + f0 + 4 * n), w1 = *(const f32x4*)(cw + DFF + f0 + 4 * n), w2 = *(const f32x4*)(cw + 2 * DFF + f0 + 4 * n), bb = *(const f32x4*)(cb + f0 + 4 * n);
#pragma unroll
            for (int ai = 0; ai < 2; ++ai) { const int blk = 2 * ai + wr;
                f32x4 rc_prev = blk > 0 ? *(const LAS f32x4*)(xl + (blk - 1) * 128 + cl0 + 4 * n) : (f32x4){0.f, 0.f, 0.f, 0.f};
                const f32x4 bot = blk < 3 ? *(const LAS f32x4*)(xf + (blk + 1) * 128 + cl0 + 4 * n) : (f32x4){0.f, 0.f, 0.f, 0.f};
                f32x4 lc_cur; SHF4(lc_cur, acc[ai][0][0][n], src_dn);
#pragma unroll
                for (int m = 0; m < 4; ++m) {
                    f32x4 rc_cur, lc_next; SHF4(rc_cur, acc[ai][0][m][n], src_up);
                    if (m < 3) SHF4(lc_next, acc[ai][0][m + 1][n], src_dn); else lc_next = bot;
                    f32x4 pre, g;
#pragma unroll
                    for (int e = 0; e < 4; ++e) { const float up = fr == 0 ? rc_prev[e] : rc_cur[e], dn = fr == 15 ? lc_next[e] : lc_cur[e];
                        const float p = w0[e] * up + w1[e] * acc[ai][0][m][n][e] + w2[e] * dn + bb[e];
                        pre[e] = p; g[e] = gelu_tanh_f(p) * acc[ai][1][m][n][e]; }
                    const int row = u.pm * BM + ai * HALF + wr * 64 + m * 16 + fr;
                    u32x2 wv; wv.x = cvt_pk_bf16(g[0], g[1]); wv.y = cvt_pk_bf16(g[2], g[3]);
                    *(u32x2*)(G + (size_t)row * DFF + f0 + 4 * n) = wv;
                    if (blk == 0 && m == 0 && fr == 0) { float* sp = side + (size_t)u.pm * DFF + f0 + 4 * n; *(f32x4*)sp = pre; *(f32x4*)(sp + 2 * SIDE_N) = acc[ai][0][m][n]; *(f32x4*)(sp + 4 * SIDE_N) = acc[ai][1][m][n]; }
                    if (blk == 3 && m == 3 && fr == 15) { float* sp = side + (size_t)u.pm * DFF + f0 + 4 * n; *(f32x4*)(sp + SIDE_N) = pre; *(f32x4*)(sp + 3 * SIDE_N) = acc[ai][0][m][n]; *(f32x4*)(sp + 5 * SIDE_N) = acc[ai][1][m][n]; }
                    rc_prev = rc_cur; lc_cur = lc_next;
                } } }
#undef SHF4
    }
};

template <class Epi, class Sched, bool ALIGN_EPI = true, bool SP2 = true>
__device__ __forceinline__ void gemm_phase(LAS unsigned char* lds, const Gemm g, const Sched& S, const Epi& E, int wid) {
    const int lane = fresh_lane(), tid = wid * 64 + lane, wr = wid >> 2, wc = wid & 3, fr = lane & 15, fq = lane >> 4;
    const int K = g.K, nt = K / BK;
    unsigned voffA[2], voffB[2];
#pragma unroll
    for (int i = 0; i < 2; ++i) { int R, C; stage_rc(tid * 16 + i * 8192, R, C); const int Rb = Epi::PERM ? ((R & ~31) + perm32(R & 31)) : R;
        voffA[i] = (unsigned)(R * g.lda + C) * 2u; voffB[i] = (unsigned)(Rb * g.ldb + C) * 2u; }
    const size_t kstep = (size_t)(BK * 2);
    const size_t hstepA = (size_t)HALF * g.lda * 2, hstepB = (size_t)HALF * g.ldb * 2;
    const size_t tstepA = 2 * hstepA, tstepB = 2 * hstepB;
    const unsigned ldsw = (unsigned)wid * 1024u;
    const int aoff = lds_byte(wr * 64 + fr, fq * 8), boff = lds_byte(wc * 32 + fr, fq * 8);
#define PG8_SA(b, h) (((b) * 2 + (h)) * HTB)
#define PG8_SB(b, h) ((4 + (b) * 2 + (h)) * HTB)
#define PG8_STAGE(bufoff, gbase, voff) do { _Pragma("unroll") for (int _i = 0; _i < 2; ++_i) \
        __builtin_amdgcn_global_load_lds((const unsigned*)((const char*)(gbase) + (voff)[_i]), (LAS unsigned*)(lds + (bufoff) + ldsw + _i * 8192), 16, 0, 0); } while (0)
#define PG8_LDA(dst, b, h) do { _Pragma("unroll") for (int m = 0; m < 4; ++m) _Pragma("unroll") for (int k = 0; k < 2; ++k) dst[m][k] = *(const LAS bf16x8*)(lds + PG8_SA(b, h) + aoff + m * 2048 + k * 1024); } while (0)
#define PG8_LDB(dst, b, h) do { _Pragma("unroll") for (int n = 0; n < 2; ++n) _Pragma("unroll") for (int k = 0; k < 2; ++k) dst[n][k] = *(const LAS bf16x8*)(lds + PG8_SB(b, h) + boff + n * 2048 + k * 1024); } while (0)
#define PG8_MMA(ai, bj, At, Bt) do { __builtin_amdgcn_s_setprio(1); _Pragma("unroll") for (int m = 0; m < 4; ++m) _Pragma("unroll") for (int n = 0; n < 2; ++n) _Pragma("unroll") for (int k = 0; k < 2; ++k) \
        acc[ai][bj][m][n] = __builtin_amdgcn_mfma_f32_16x16x32_bf16(Bt[n][k], At[m][k], acc[ai][bj][m][n], 0, 0, 0); __builtin_amdgcn_s_setprio(0); } while (0)
#define PG8_WAIT_V(n) asm volatile("s_waitcnt vmcnt(" #n ")" ::: "memory")
#define PG8_WAIT_L(n) asm volatile("s_waitcnt lgkmcnt(" #n ")" ::: "memory")
#define PG8_BAR __builtin_amdgcn_s_barrier()
#define PG8_SCHED __builtin_amdgcn_sched_barrier(0)
    Unit cur, nxt; int ui = 0;
    if (!S.next(0, cur)) return;
    f32x4 acc[2][2][4][2];
#pragma unroll
    for (int a = 0; a < 2; ++a)
#pragma unroll
        for (int b = 0; b < 2; ++b)
#pragma unroll
            for (int m = 0; m < 4; ++m)
#pragma unroll
                for (int n = 0; n < 2; ++n) acc[a][b][m][n] = (f32x4){0.f, 0.f, 0.f, 0.f};
    bf16x8 At[4][2], B0[2][2], B1[2][2];
    const char* cA = (const char*)(cur.sub ? g.A2 : g.A) + (size_t)cur.pm * tstepA; const char* cB = (const char*)(cur.sub ? g.Bt2 : g.Bt) + (size_t)cur.pn * tstepB;
    S.a_ready(cur);
    if constexpr (SP2) {
        PG8_STAGE(PG8_SB(0, 0), cB, voffB); PG8_STAGE(PG8_SB(0, 1), cB + hstepB, voffB); PG8_STAGE(PG8_SA(0, 0), cA, voffA); PG8_STAGE(PG8_SA(0, 1), cA + hstepA, voffA);
        if (wr == 1) PG8_BAR;
        PG8_WAIT_V(2); PG8_BAR;
        PG8_STAGE(PG8_SB(1, 0), cB + kstep, voffB); PG8_STAGE(PG8_SA(1, 0), cA + kstep, voffA); PG8_STAGE(PG8_SB(1, 1), cB + hstepB + kstep, voffB);
        PG8_WAIT_V(6); PG8_BAR;
    } else {
        PG8_STAGE(PG8_SB(0, 0), cB, voffB); PG8_STAGE(PG8_SA(0, 0), cA, voffA); PG8_STAGE(PG8_SB(0, 1), cB + hstepB, voffB); PG8_STAGE(PG8_SA(0, 1), cA + hstepA, voffA);
        if (wr == 1) PG8_BAR;
        PG8_WAIT_V(4); PG8_BAR;
        PG8_STAGE(PG8_SB(1, 0), cB + kstep, voffB); PG8_STAGE(PG8_SA(1, 0), cA + kstep, voffA); PG8_STAGE(PG8_SB(1, 1), cB + hstepB + kstep, voffB);
        PG8_WAIT_V(6); PG8_BAR;
    }
    for (;;) {
        const bool has_next = S.next(ui + 1, nxt);
        const char* nA = has_next ? (const char*)(nxt.sub ? g.A2 : g.A) + (size_t)nxt.pm * tstepA : cA; const char* nB = has_next ? (const char*)(nxt.sub ? g.Bt2 : g.Bt) + (size_t)nxt.pn * tstepB : cB;
        for (int t = 0; t < nt; t += 2) {
            const bool last = (t == nt - 2);
            const char* a1 = cA + (size_t)(t + 1) * kstep;
            const char* a2 = last ? nA : cA + (size_t)(t + 2) * kstep; const char* b2 = last ? nB : cB + (size_t)(t + 2) * kstep;
            const char* a3 = a2 + kstep; const char* b3 = b2 + kstep;
            if (last && has_next) S.a_ready(nxt);
            if constexpr (SP2) {
            PG8_LDB(B0, 0, 0); PG8_LDB(B1, 0, 1); PG8_SCHED; PG8_LDA(At, 0, 0); PG8_STAGE(PG8_SA(1, 1), a1 + hstepA, voffA);
            PG8_WAIT_V(8); PG8_WAIT_L(0); PG8_BAR; PG8_MMA(0, 0, At, B0); PG8_MMA(0, 1, At, B1); PG8_BAR; PG8_SCHED;
            PG8_LDA(At, 0, 1); PG8_STAGE(PG8_SB(0, 0), b2, voffB); PG8_STAGE(PG8_SB(0, 1), b2 + hstepB, voffB); PG8_STAGE(PG8_SA(0, 0), a2, voffA);
            PG8_WAIT_V(8); PG8_WAIT_L(0); PG8_BAR; PG8_MMA(1, 0, At, B0); PG8_MMA(1, 1, At, B1); PG8_BAR; PG8_SCHED;
            PG8_LDB(B0, 1, 0); PG8_LDB(B1, 1, 1); PG8_SCHED; PG8_LDA(At, 1, 0); PG8_STAGE(PG8_SA(0, 1), a2 + hstepA, voffA);
            PG8_WAIT_V(8); PG8_WAIT_L(0); PG8_BAR; PG8_MMA(0, 0, At, B0); PG8_MMA(0, 1, At, B1); PG8_BAR; PG8_SCHED;
            PG8_LDA(At, 1, 1); PG8_STAGE(PG8_SB(1, 0), b3, voffB); PG8_STAGE(PG8_SB(1, 1), b3 + hstepB, voffB); PG8_STAGE(PG8_SA(1, 0), a3, voffA);
            PG8_WAIT_V(8); PG8_WAIT_L(0); PG8_BAR; PG8_MMA(1, 0, At, B0); PG8_MMA(1, 1, At, B1); PG8_BAR; PG8_SCHED;
            } else {
            PG8_LDB(B0, 0, 0); PG8_SCHED; PG8_LDA(At, 0, 0); PG8_STAGE(PG8_SA(1, 1), a1 + hstepA, voffA);
            PG8_WAIT_L(8); PG8_BAR; PG8_WAIT_L(0); PG8_MMA(0, 0, At, B0); PG8_BAR; PG8_SCHED;
            PG8_LDB(B1, 0, 1); PG8_STAGE(PG8_SB(0, 0), b2, voffB);
            PG8_BAR; PG8_WAIT_L(0); PG8_MMA(0, 1, At, B1); PG8_BAR;
            PG8_LDA(At, 0, 1); PG8_STAGE(PG8_SA(0, 0), a2, voffA);
            PG8_BAR; PG8_WAIT_L(0); PG8_MMA(1, 0, At, B0); PG8_BAR; PG8_SCHED;
            PG8_STAGE(PG8_SB(0, 1), b2 + hstepB, voffB);
            PG8_WAIT_V(6); PG8_BAR; PG8_MMA(1, 1, At, B1); PG8_BAR;
            PG8_LDB(B0, 1, 0); PG8_SCHED; PG8_LDA(At, 1, 0); PG8_STAGE(PG8_SA(0, 1), a2 + hstepA, voffA);
            PG8_WAIT_L(8); PG8_BAR; PG8_WAIT_L(0); PG8_MMA(0, 0, At, B0); PG8_BAR; PG8_SCHED;
            PG8_LDB(B1, 1, 1); PG8_STAGE(PG8_SB(1, 0), b3, voffB);
            PG8_BAR; PG8_WAIT_L(0); PG8_MMA(0, 1, At, B1); PG8_BAR;
            PG8_LDA(At, 1, 1); PG8_STAGE(PG8_SA(1, 0), a3, voffA);
            PG8_BAR; PG8_WAIT_L(0); PG8_MMA(1, 0, At, B0); PG8_BAR; PG8_SCHED;
            PG8_STAGE(PG8_SB(1, 1), b3 + hstepB, voffB);
            PG8_WAIT_V(6); PG8_BAR; PG8_MMA(1, 1, At, B1); PG8_BAR;
            }
        }
        if constexpr (ALIGN_EPI) { if (wr == 0) PG8_BAR; }
        if constexpr (!Epi::AFTER_DRAIN) { E(acc, cur, wr, wc, fr, fq); S.done(cur); }
        if (!has_next) break;
        if (nxt.sub == 0) {
#pragma unroll
        for (int a = 0; a < 2; ++a)
#pragma unroll
            for (int b = 0; b < 2; ++b)
#pragma unroll
                for (int m = 0; m < 4; ++m)
#pragma unroll
                    for (int n = 0; n < 2; ++n) acc[a][b][m][n] = (f32x4){0.f, 0.f, 0.f, 0.f};
        }
        cur = nxt; cA = nA; cB = nB; ++ui;
        if constexpr (ALIGN_EPI) { if (wr == 1) PG8_BAR; }
    }
    PG8_WAIT_V(0);
    if constexpr (!ALIGN_EPI) { if (wr == 0) PG8_BAR; }
    PG8_BAR;
#undef PG8_SA
#undef PG8_SB
#undef PG8_STAGE
#undef PG8_LDA
#undef PG8_LDB
#undef PG8_MMA
#undef PG8_WAIT_V
#undef PG8_WAIT_L
#undef PG8_BAR
#undef PG8_SCHED
}
}

namespace mla {
constexpr int NW = 8, QBLK = 32, KVBLK = 64;
constexpr float SCALE = 0.07216878364870322f;
constexpr float THR = 8.f;
constexpr int SDEPTH = 1;
constexpr int LDQ = 3072, LDKN = 2048, LDKP = 64, LDV = 2048, LDO = 2048;
constexpr int SHM_V = KVBLK * 128 * 2, SHM_K = KVBLK * 400, SHM_QPE = 2 * SHM_V + 2 * SHM_K + NW * 64 * 4, SHM_ATTN = SHM_QPE + NW * 8704;
#define KSWZ(row, colB) ((row) * 400 + (colB))
#define SBAR() __builtin_amdgcn_sched_barrier(0)
__device__ __forceinline__ int crow(int r, int hi) { return (r & 3) + 8 * (r >> 2) + 4 * hi; }

constexpr int NQR = 4, NQL = 12 - NQR;
__device__ __forceinline__ int qlds_off(int r32, int c) { return r32 * 272 + c * 16; }
__device__ __forceinline__ int v_st(int k, int c) { const int kk = (k & ~0xC) | ((k & 4) << 1) | ((k & 8) >> 1); return ((kk >> 3) * 4 + (c >> 5)) * 512 + ((kk & 7) * 32 + (c & 31)) * 2; }
__device__ __forceinline__ int v_rd_base(int lane) { return ((lane & 3) << 3) | (((lane >> 2) & 3) << 6) | (((lane >> 4) & 1) << 5) | (((lane >> 5) & 1) << 8); }
constexpr int v_rd_off(int d0, int ks, int half) { return d0 * 512 + ks * 4096 + half * 2048; }
template <int OFF> __device__ __forceinline__ s16x4 tr_read(int vb) {
  s16x4 r; asm volatile("ds_read_b64_tr_b16 %0, %1 offset:%2" : "=&v"(r) : "v"(vb), "i"(OFF) : "memory"); return r;
}
#ifndef MLA_KLA
#define MLA_KLA 4
#endif
#ifndef MLA_PVA
#define MLA_PVA 6
#endif
constexpr int PVA = MLA_PVA, KLA = MLA_KLA;
template <int I> __device__ __forceinline__ void tr_pair(s16x4& lo, s16x4& hi_, int vb) { lo = tr_read<v_rd_off(I >> 2, I & 3, 0)>(vb); hi_ = tr_read<v_rd_off(I >> 2, I & 3, 1)>(vb); }
template <int I> __device__ __forceinline__ void tr_pairs(s16x4 (&LO)[16], s16x4 (&HI)[16], int vb) { if constexpr (I < PVA) { tr_pair<I>(LO[I], HI[I], vb); tr_pairs<I + 1>(LO, HI, vb); } }
template <int I> __device__ __forceinline__ void pv_step(f32x16* o, s16x4 (&LO)[16], s16x4 (&HI)[16], int vb, bf16x8 pa0, bf16x8 pa1, bf16x8 pa2, bf16x8 pa3) {
  if constexpr (I + PVA < 16) tr_pair<I + PVA>(LO[I + PVA], HI[I + PVA], vb);
  if constexpr (I + PVA < 16) asm volatile("s_waitcnt lgkmcnt(%0)" :: "n"(2 * PVA) : "memory");
  else asm volatile("s_waitcnt lgkmcnt(%0)" :: "n"(2 * (15 - I)) : "memory");
  SBAR();
  const bf16x8 pa = (I & 3) == 0 ? pa0 : ((I & 3) == 1 ? pa1 : ((I & 3) == 2 ? pa2 : pa3));
  const bf16x8 bv = (bf16x8){LO[I][0], LO[I][1], LO[I][2], LO[I][3], HI[I][0], HI[I][1], HI[I][2], HI[I][3]};
  o[I >> 2] = __builtin_amdgcn_mfma_f32_32x32x16_bf16(pa, bv, o[I >> 2], 0, 0, 0); SBAR();
}
template <int I> __device__ __forceinline__ void pv_steps(f32x16* o, s16x4 (&LO)[16], s16x4 (&HI)[16], int vb, bf16x8 pa0, bf16x8 pa1, bf16x8 pa2, bf16x8 pa3) {
  if constexpr (I < 16) { pv_step<I>(o, LO, HI, vb, pa0, pa1, pa2, pa3); pv_steps<I + 1>(o, LO, HI, vb, pa0, pa1, pa2, pa3); }
}
template <bool DO_PV>
__device__ __forceinline__ void m_phase(f32x16& p0, f32x16& p1, f32x16* o, const char* Ks, const bf16x8* qr, const char* qls, int vb, int r32, int hi,
                                        bf16x8 pa0, bf16x8 pa1, bf16x8 pa2, bf16x8 pa3) {
  bf16x8 B0[12], B1[12], QL[12]; s16x4 LO[16], HI[16];
  const char* k0p = Ks + KSWZ(r32, hi * 16); const char* k1p = Ks + KSWZ(32 + r32, hi * 16); const char* qp = qls + qlds_off(r32, hi);
#define KLD(d) do { B0[d] = *reinterpret_cast<const bf16x8*>(k0p + (d) * 32); B1[d] = *reinterpret_cast<const bf16x8*>(k1p + (d) * 32); \
    if ((d) >= NQR) QL[d] = *reinterpret_cast<const bf16x8*>(qp + ((d) - NQR) * 32); } while (0)
  SBAR();
#pragma unroll
  for (int d = 0; d < KLA; ++d) KLD(d);
  SBAR();
  p0 = f32x16{}; p1 = f32x16{};
#pragma unroll
  for (int d = 0; d < 12; ++d) {
    if (d + KLA < 12) { KLD(d + KLA); }
    SBAR();
    const bf16x8 q = d < NQR ? qr[d < NQR ? d : 0] : QL[d];
    p0 = __builtin_amdgcn_mfma_f32_32x32x16_bf16(B0[d], q, p0, 0, 0, 0);
    p1 = __builtin_amdgcn_mfma_f32_32x32x16_bf16(B1[d], q, p1, 0, 0, 0); SBAR();
  }
#undef KLD
  if constexpr (DO_PV) {
    tr_pairs<0>(LO, HI, vb); SBAR();
    pv_steps<0>(o, LO, HI, vb, pa0, pa1, pa2, pa3);
  }
}
__device__ __forceinline__ void pv_pipe(f32x16* o, int vb, bf16x8 pa0, bf16x8 pa1, bf16x8 pa2, bf16x8 pa3) {
  s16x4 LO[16], HI[16];
  SBAR(); tr_pairs<0>(LO, HI, vb); SBAR();
  pv_steps<0>(o, LO, HI, vb, pa0, pa1, pa2, pa3);
}
__device__ __forceinline__ void softmax_tile(f32x16& p0, f32x16& p1, float& m_reg, float& l_reg, float& alpha, bf16x8& pa0, bf16x8& pa1, bf16x8& pa2, bf16x8& pa3) {
  constexpr float C = SCALE * 1.4426950408889634f;
  float pmax = p0[0];
#pragma unroll
  for (int r = 1; r < 16; ++r) pmax = fmaxf(pmax, p0[r]);
#pragma unroll
  for (int r = 0; r < 16; ++r) pmax = fmaxf(pmax, p1[r]);
  { auto rr = __builtin_amdgcn_permlane32_swap(__float_as_uint(pmax), __float_as_uint(pmax), false, false);
    pmax = fmaxf(__uint_as_float(rr[0]), __uint_as_float(rr[1])); }
  float mn;
  if (__builtin_expect(__all(pmax - m_reg <= THR / SCALE), 1)) { mn = m_reg; alpha = 1.f; }
  else { mn = fmaxf(m_reg, pmax); alpha = __builtin_amdgcn_exp2f((m_reg - mn) * C); m_reg = mn; }
  const float mnC = -mn * C;
#pragma unroll
  for (int r = 0; r < 16; ++r) p0[r] = __builtin_amdgcn_exp2f(fmaf(p0[r], C, mnC));
#pragma unroll
  for (int r = 0; r < 16; ++r) p1[r] = __builtin_amdgcn_exp2f(fmaf(p1[r], C, mnC));
  float ps = 0;
#pragma unroll
  for (int r = 0; r < 16; ++r) ps += p0[r];
#pragma unroll
  for (int r = 0; r < 16; ++r) ps += p1[r];
  { auto rr = __builtin_amdgcn_permlane32_swap(__float_as_uint(ps), __float_as_uint(ps), false, false);
    ps = __uint_as_float(rr[0]) + __uint_as_float(rr[1]); }
  l_reg = l_reg * alpha + ps;
#define PK4(P, BASE, OUT) do { unsigned a0 = cvt_pk_bf16(P[BASE + 0], P[BASE + 1]), a1 = cvt_pk_bf16(P[BASE + 2], P[BASE + 3]);   \
    unsigned b0 = cvt_pk_bf16(P[BASE + 4], P[BASE + 5]), b1 = cvt_pk_bf16(P[BASE + 6], P[BASE + 7]);                              \
    auto r0 = __builtin_amdgcn_permlane32_swap(a0, b0, false, false); auto r1 = __builtin_amdgcn_permlane32_swap(a1, b1, false, false); \
    u32x4 w = {r0[0], r1[0], r0[1], r1[1]}; OUT = *reinterpret_cast<bf16x8*>(&w); } while (0)
  PK4(p0, 0, pa0); PK4(p0, 8, pa1); PK4(p1, 0, pa2); PK4(p1, 8, pa3);
#undef PK4
}
#define MLA_BAR() do { SBAR(); asm volatile("s_waitcnt lgkmcnt(0)" ::: "memory"); __builtin_amdgcn_s_barrier(); asm volatile("" ::: "memory"); SBAR(); } while (0)
__device__ __forceinline__ void attn_body2(const bf16_t* __restrict__ Qb, const bf16_t* __restrict__ Kn, const bf16_t* __restrict__ Kp, const bf16_t* __restrict__ Vh,
                                           bf16_t* __restrict__ Ob, int seq, int pos0, const float* __restrict__ tcos, const float* __restrict__ tsin, char* lds, int wid) {
  const int lane = fresh_lane(), tid = wid * 64 + lane, r32 = lane & 31, hi = lane >> 5, half = wid >> 2;
  char* V_lds = lds; char* K_lds = lds + 2 * SHM_V;
  float* ws = (float*)(lds + 2 * SHM_V + 2 * SHM_K) + wid * 64; float* li_l = ws; float* al_l = ws + 32;
  float m_reg = -1e30f, l_reg = 0; f32x16 o[4] = {}; bf16x8 qr[NQR]; char* qpe = lds + SHM_QPE + wid * 8704;
  const bf16_t* Qw = Qb + (long)(wid * QBLK + r32) * LDQ + hi * 8;
#pragma unroll
  for (int d0 = 0; d0 < (NQR < 8 ? NQR : 8); ++d0) qr[d0] = *reinterpret_cast<const bf16x8*>(Qw + d0 * 16);
#pragma unroll
  for (int d0 = NQR; d0 < 8; ++d0) *reinterpret_cast<bf16x8*>(qpe + qlds_off(r32, (d0 - NQR) * 2 + hi)) = *reinterpret_cast<const bf16x8*>(Qw + d0 * 16);
  {
    const int pos = pos0 + wid * QBLK + r32;
#pragma unroll
    for (int part = 0; part < 2; ++part) {
      const float* cp = tcos + (size_t)pos * 32 + part * 16 + hi * 8; const float* sp = tsin + (size_t)pos * 32 + part * 16 + hi * 8;
      const f32x4 c0 = *(const f32x4*)cp, c1 = *(const f32x4*)(cp + 4), s0 = *(const f32x4*)sp, s1 = *(const f32x4*)(sp + 4);
      bf16x8 xa = *reinterpret_cast<const bf16x8*>(Qw + (8 + part) * 16), xb = *reinterpret_cast<const bf16x8*>(Qw + (10 + part) * 16); u32x4 wa, wb;
      float ya[8], yb[8];
#pragma unroll
      for (int j = 0; j < 8; ++j) { const float x1 = bf2f((unsigned short)xa[j]), x2 = bf2f((unsigned short)xb[j]); const float c = j < 4 ? c0[j] : c1[j - 4], s = j < 4 ? s0[j] : s1[j - 4];
        ya[j] = x1 * c - x2 * s; yb[j] = x1 * s + x2 * c; }
      wa.x = cvt_pk_bf16(ya[0], ya[1]); wa.y = cvt_pk_bf16(ya[2], ya[3]); wa.z = cvt_pk_bf16(ya[4], ya[5]); wa.w = cvt_pk_bf16(ya[6], ya[7]);
      wb.x = cvt_pk_bf16(yb[0], yb[1]); wb.y = cvt_pk_bf16(yb[2], yb[3]); wb.z = cvt_pk_bf16(yb[4], yb[5]); wb.w = cvt_pk_bf16(yb[6], yb[7]);
      if constexpr (8 + 1 < NQR) qr[8 + part] = *reinterpret_cast<bf16x8*>(&wa); else *reinterpret_cast<u32x4*>(qpe + qlds_off(r32, (8 + part - NQR) * 2 + hi)) = wa;
      if constexpr (10 + 1 < NQR) qr[10 + part] = *reinterpret_cast<bf16x8*>(&wb); else *reinterpret_cast<u32x4*>(qpe + qlds_off(r32, (10 + part - NQR) * 2 + hi)) = wb;
    }
  }
  const int sr = tid >> 4, sc = (tid & 15) * 8, vst0 = v_st(sr, sc), vst1 = v_st(32 + sr, sc);
  const int pr = tid >> 3, pc = (tid & 7) * 8;
  const int vb0 = (int)(uintptr_t)V_lds + v_rd_base(lane);
  bf16x8 st_vs0, st_vs1, st_ks0, st_ks1, st_kp;
#define LOADK(kt) do { st_ks0 = *(const bf16x8*)(&Kn[(long)((kt) * KVBLK + sr) * LDKN + sc]); st_ks1 = *(const bf16x8*)(&Kn[(long)((kt) * KVBLK + 32 + sr) * LDKN + sc]); \
    st_kp = *(const bf16x8*)(&Kp[(long)((kt) * KVBLK + pr) * LDKP + pc]); } while (0)
#define LOADV(vt) do { st_vs0 = *(const bf16x8*)(&Vh[(long)((vt) * KVBLK + sr) * LDV + sc]); st_vs1 = *(const bf16x8*)(&Vh[(long)((vt) * KVBLK + 32 + sr) * LDV + sc]); } while (0)
#define WRITEK(b) do { char* kb_ = K_lds + (b) * SHM_K; *(bf16x8*)(kb_ + KSWZ(sr, sc * 2)) = st_ks0; *(bf16x8*)(kb_ + KSWZ(32 + sr, sc * 2)) = st_ks1; *(bf16x8*)(kb_ + KSWZ(pr, 256 + pc * 2)) = st_kp; } while (0)
#define WRITEV(b) do { char* vb_ = V_lds + (b) * SHM_V; *(bf16x8*)(vb_ + vst0) = st_vs0; *(bf16x8*)(vb_ + vst1) = st_vs1; } while (0)
#define RESC(a) do { if (__any((a) < 1.f)) { if (hi == 0) al_l[r32] = (a); asm volatile("s_waitcnt lgkmcnt(0)" ::: "memory"); \
    _Pragma("unroll") for (int d = 0; d < 4; ++d) _Pragma("unroll") for (int r = 0; r < 16; ++r) o[d][r] *= al_l[crow(r, hi)]; } } while (0)
  const int NT = seq / KVBLK;
  LOADK(0); LOADV(0); WRITEK(0); WRITEV(0); LOADK(1); WRITEK(1);
  if (2 < NT) LOADK(2);
  LOADV(1);
  MLA_BAR();
  if (half == 1) MLA_BAR();
  f32x16 p0, p1; float alpha; bf16x8 pa0, pa1, pa2, pa3;
#define VPHASE(t) do { softmax_tile(p0, p1, m_reg, l_reg, alpha, pa0, pa1, pa2, pa3); RESC(alpha); \
    const int n_ = (t) + half - 1; \
    if (n_ >= 0) { const int kb_i = n_ & 1, vb_i = (n_ + 1) & 1; if (n_ + 2 < NT) WRITEK(kb_i); if (n_ + 1 < NT) WRITEV(vb_i); \
      if (n_ + 3 < NT) LOADK(n_ + 3); if (n_ + 2 < NT) LOADV(n_ + 2); } } while (0)
  pa0 = pa1 = pa2 = pa3 = bf16x8{};
  m_phase<false>(p0, p1, o, K_lds, qr, qpe, vb0, r32, hi, pa0, pa1, pa2, pa3); MLA_BAR();
  VPHASE(0); MLA_BAR();
  for (int t = 1; t + 1 < NT; t += 2) {
    m_phase<true>(p0, p1, o, K_lds + SHM_K, qr, qpe, vb0, r32, hi, pa0, pa1, pa2, pa3); MLA_BAR();
    VPHASE(t); MLA_BAR();
    m_phase<true>(p0, p1, o, K_lds, qr, qpe, vb0 + (int)SHM_V, r32, hi, pa0, pa1, pa2, pa3); MLA_BAR();
    VPHASE(t + 1); MLA_BAR();
  }
  { const int t = NT - 1;
    m_phase<true>(p0, p1, o, K_lds + SHM_K, qr, qpe, vb0, r32, hi, pa0, pa1, pa2, pa3); MLA_BAR();
    VPHASE(t); MLA_BAR(); }
  pv_pipe(o, vb0 + (int)SHM_V, pa0, pa1, pa2, pa3); MLA_BAR();
  if (half == 0) MLA_BAR();
  if (hi == 0) li_l[r32] = l_reg; asm volatile("s_waitcnt lgkmcnt(0)" ::: "memory");
  float rli[16];
#pragma unroll
  for (int r = 0; r < 16; ++r) rli[r] = __builtin_amdgcn_rcpf(li_l[crow(r, hi)]);
  bf16_t* Ow = Ob + (long)(wid * QBLK) * LDO;
#pragma unroll
  for (int r = 0; r < 16; ++r) { int orow = crow(r, hi);
#pragma unroll
    for (int d0 = 0; d0 < 4; ++d0) Ow[(long)orow * LDO + d0 * 32 + r32] = (bf16_t)(cvt_pk_bf16(o[d0][r] * rli[r], 0.f) & 0xffffu); }
  MLA_BAR();
#undef LOADK
#undef LOADV
#undef WRITEK
#undef WRITEV
#undef RESC
#undef VPHASE
}
}

#define XB_TMO      128
#define XB_XCNT(j)  (256  + 64 * (j))
#define XB_XSUB(j)  (1280 + 64 * (j))
#define XB_XGEN(j)  (2304 + 64 * (j))
#define XB_TOP      3328
#define XB_TOPGEN   3392
#define XCD_BAR_WORDS 3456
#define XB_SPIN_CAP (1u << 18)
__device__ __forceinline__ unsigned xb_ld(unsigned* p)              { return __hip_atomic_load(p, __ATOMIC_RELAXED, __HIP_MEMORY_SCOPE_AGENT); }
__device__ __forceinline__ unsigned xb_add(unsigned* p, unsigned v) { return __hip_atomic_fetch_add(p, v, __ATOMIC_RELAXED, __HIP_MEMORY_SCOPE_AGENT); }
__device__ __forceinline__ unsigned xb_xcc_id() { return (unsigned)__builtin_amdgcn_s_getreg((3 << 11) | 20) & 0xFu; }
#define XB_SPIN(cond, bar) do { unsigned _sp = 0; while (cond) { __builtin_amdgcn_s_sleep(1); \
    if ((++_sp & 255u) == 0u) { if (xb_ld(&(bar)[XB_TMO])) break; if (_sp > XB_SPIN_CAP) { atomicAdd(&(bar)[XB_TMO], 1u); break; } } } } while (0)
struct XcdBarrier { unsigned* bar; unsigned x; volatile LAS unsigned* st; int wave; };
__device__ __forceinline__ XcdBarrier xcd_barrier_post(unsigned* bar, volatile LAS unsigned* st, int wave) {
    XcdBarrier b; b.bar = bar; b.x = xb_xcc_id(); b.st = st; b.wave = wave;
    if (wave == 0 && fresh_lane() == 0) (void)xb_add(&bar[XB_XCNT(b.x)], 1u);
    return b;
}
__device__ __forceinline__ void xcd_barrier_complete(unsigned* bar, unsigned x, unsigned& nloc, unsigned& nx) {
    const unsigned G = gridDim.x * gridDim.y * gridDim.z;
    unsigned sum, cnt, mine, sp = 0u;
    for (;;) {
        sum = 0u; cnt = 0u; mine = 0u;
#pragma unroll
        for (unsigned j = 0; j < 16; ++j) { const unsigned c = xb_ld(&bar[XB_XCNT(j)]); sum += c; cnt += (c > 0u) ? 1u : 0u; mine = (j == x) ? c : mine; }
        if (sum == G) break;
        __builtin_amdgcn_s_sleep(1);
        if ((++sp & 255u) == 0u) { if (xb_ld(&bar[XB_TMO])) break; if (sp > XB_SPIN_CAP) { atomicAdd(&bar[XB_TMO], 1u); break; } }
    }
    nloc = mine > 0u ? mine : 1u; nx = cnt > 0u ? cnt : 1u;
}
__device__ __forceinline__ void xcd_barrier(const XcdBarrier& b) {
    asm volatile("s_waitcnt vmcnt(0)" ::: "memory");
    __syncthreads();
    if (b.wave == 0 && fresh_lane() == 0) {
        unsigned* bar = b.bar;
        __builtin_amdgcn_s_waitcnt(0);
        unsigned nloc = b.st[0], nx = b.st[1];
        if (nloc == 0u) { xcd_barrier_complete(bar, b.x, nloc, nx); b.st[0] = nloc; b.st[1] = nx; }
        const unsigned old = xb_add(&bar[XB_XSUB(b.x)], 1u);
        const unsigned gen = old / nloc;
        if (old + 1u == (gen + 1u) * nloc) {
            __builtin_amdgcn_fence(__ATOMIC_RELEASE, "agent");
            asm volatile("s_waitcnt vmcnt(0)" ::: "memory");
            const unsigned og = xb_add(&bar[XB_TOP], 1u);
            const unsigned tg = og / nx;
            if (og + 1u == (tg + 1u) * nx) xb_add(&bar[XB_TOPGEN], 1u);
            else XB_SPIN(xb_ld(&bar[XB_TOPGEN]) == tg, bar);
            __builtin_amdgcn_fence(__ATOMIC_ACQUIRE, "agent");
            xb_add(&bar[XB_XGEN(b.x)], 1u);
            asm volatile("s_waitcnt vmcnt(0)" ::: "memory");
        } else {
            XB_SPIN(xb_ld(&bar[XB_XGEN(b.x)]) == gen, bar);
            __builtin_amdgcn_fence(__ATOMIC_ACQUIRE, "agent");
            asm volatile("s_waitcnt vmcnt(0)" ::: "memory");
        }
    }
    __syncthreads();
}

struct Frame {
    LAS unsigned char* lds; char* ldsg;
    volatile LAS unsigned* MISC;
    unsigned* ctl;
    int tid, lane, wave, vcu, G;
    const float* in[23]; float* out; unsigned char* ws;
};
__device__ __forceinline__ float wave_sum(float v) {
#pragma unroll
    for (int o = 1; o < 64; o <<= 1) v += __shfl_xor(v, o);
    return v;
}
__device__ __forceinline__ const float* xrow(const Frame& F, int m) { return m < MP ? F.in[0] + (size_t)m * DM : F.in[1] + (size_t)(m - MP) * DM; }
__device__ __forceinline__ int seq_of(int m) { return m < MP ? (m >> 11) : 4; }
__device__ __forceinline__ int pos_of(int m) { return m < MP ? (m & (LP - 1)) : (m - MP); }

__device__ __forceinline__ void p0_mod(Frame& F) {
    LAS float* sc = (LAS float*)F.lds;
    LAS float* red = (LAS float*)(F.lds + 81920);
    const float* cpr = F.in[2]; const float* csm = F.in[3]; const float* wada = F.in[4]; const float* bada = F.in[5];
    float* mod = (float*)(F.ws + WS_MOD);
    for (int i = F.tid; i < 5 * DM; i += 512) { const float c = (i < 4 * DM) ? cpr[i] : csm[i - 4 * DM]; sc[i] = c * fast_sigmoid(c); }
    __syncthreads();
    const int cg = F.tid % 24, kr = F.tid / 24;
    for (int chunk = F.vcu; chunk < 256; chunk += F.G) {
        float a0[4] = {0, 0, 0, 0}, a1[4] = {0, 0, 0, 0}, a2[4] = {0, 0, 0, 0}, a3[4] = {0, 0, 0, 0}, a4[4] = {0, 0, 0, 0};
        if (kr < 21) {
            const float* wp = wada + chunk * 96 + cg * 4;
#pragma unroll 4
            for (int k = kr; k < DM; k += 21) {
                const f32x4 w = *(const f32x4*)(wp + (size_t)k * NMOD);
                const float s0 = sc[k], s1 = sc[DM + k], s2 = sc[2 * DM + k], s3 = sc[3 * DM + k], s4 = sc[4 * DM + k];
#pragma unroll
                for (int e = 0; e < 4; ++e) { a0[e] += s0 * w[e]; a1[e] += s1 * w[e]; a2[e] += s2 * w[e]; a3[e] += s3 * w[e]; a4[e] += s4 * w[e]; }
            }
#pragma unroll
            for (int e = 0; e < 4; ++e) { red[(kr * 5 + 0) * 96 + cg * 4 + e] = a0[e]; red[(kr * 5 + 1) * 96 + cg * 4 + e] = a1[e]; red[(kr * 5 + 2) * 96 + cg * 4 + e] = a2[e];
                red[(kr * 5 + 3) * 96 + cg * 4 + e] = a3[e]; red[(kr * 5 + 4) * 96 + cg * 4 + e] = a4[e]; }
        }
        __syncthreads();
        if (F.tid < 480) { const int r = F.tid / 96, c = F.tid % 96; float s = 0.f;
            for (int q = 0; q < 21; ++q) s += red[(q * 5 + r) * 96 + c];
            mod[r * NMOD + chunk * 96 + c] = s + bada[chunk * 96 + c]; }
        __syncthreads();
    }
}
__device__ __forceinline__ void p0_transpose_item(const float* W, int ldw, int n0, int k0, bf16_t* WT, int drow0, int ldk, const float* kscale, LAS float* scr, int lane) {
#pragma unroll 8
    for (int i = 0; i < 32; ++i) { const int kk = 2 * i + (lane >> 5); float v = W[(size_t)(k0 + kk) * ldw + n0 + (lane & 31)]; if (kscale) v *= kscale[k0 + kk]; scr[kk * 33 + (lane & 31)] = v; }
    LDS_WAIT(); asm volatile("" ::: "memory");
    const int c = lane & 7;
#pragma unroll
    for (int j = 0; j < 4; ++j) { const int n = (lane >> 3) + 8 * j; const LAS float* s = scr + (8 * c) * 33 + n;
        u32x4 o; o.x = cvt_pk_bf16(s[0 * 33], s[1 * 33]); o.y = cvt_pk_bf16(s[2 * 33], s[3 * 33]); o.z = cvt_pk_bf16(s[4 * 33], s[5 * 33]); o.w = cvt_pk_bf16(s[6 * 33], s[7 * 33]);
        *(u32x4*)(WT + (size_t)(drow0 + n) * ldk + k0 + 8 * c) = o; }
    LDS_WAIT(); asm volatile("" ::: "memory");
}
__device__ __forceinline__ int zin_dst_row(int n0) {
    if (n0 < 4096) return n0;
    if (n0 < 6144) return 13824 + (n0 - 4096);
    if (n0 < 7040) return 4096 + (n0 - 6144);
    if (n0 < 7552) return 5120 + (n0 - 7040);
    if (n0 < 7616) return 4992 + (n0 - 7552);
    if (n0 < 11712) return 5632 + (n0 - 7616);
    return 9728 + (n0 - 11712);
}
__device__ __forceinline__ void p0_weights(Frame& F) {
    LAS float* scr = (LAS float*)(F.lds + F.wave * 16384);
    const int gw = F.vcu * NWAVES + F.wave, NGW = F.G * NWAVES;
    constexpr int I_IN = (DM / 64) * (INW / 32), I_UQ = (QLORA / 64) * (3072 / 32), I_UKV = (KVLORA / 64) * (4096 / 32), I_NA = (NAW / 64) * (DM / 32), I_MLA = I_NA,
                  I_OUT = (DM / 64) * (DM / 32), I_FFN = (DM / 64) * (2 * DFF / 32), I_DOWN = (DFF / 64) * (DM / 32);
    constexpr int NITEMS = I_IN + I_UQ + I_UKV + I_NA + I_MLA + I_OUT + I_FFN + I_DOWN;
    for (int it = gw; it < NITEMS; it += NGW) {
        int r = it;
        if (r < I_IN) { const int nblk = INW / 32, kb = r / nblk, nb = r % nblk; p0_transpose_item(F.in[8], INW, 32 * nb, 64 * kb, (bf16_t*)(F.ws + WS_BIN), zin_dst_row(32 * nb), DM, nullptr, scr, F.lane); continue; } r -= I_IN;
        if (r < I_UQ) { const int nblk = 3072 / 32, kb = r / nblk, nb = r % nblk; p0_transpose_item(F.in[11], 3072, 32 * nb, 64 * kb, (bf16_t*)(F.ws + WS_BUQ), 32 * nb, QLORA, F.in[10], scr, F.lane); continue; } r -= I_UQ;
        if (r < I_UKV) { const int nblk = 4096 / 32, kb = r / nblk, nb = r % nblk; p0_transpose_item(F.in[13], 4096, 32 * nb, 64 * kb, (bf16_t*)(F.ws + WS_BUKV), 32 * nb, KVLORA, F.in[12], scr, F.lane); continue; } r -= I_UKV;
        if (r < I_NA) { const int nblk = DM / 32, kb = r / nblk, nb = r % nblk; p0_transpose_item(F.in[14], DM, 32 * nb, 64 * kb, (bf16_t*)(F.ws + WS_BNA), 32 * nb, NAW, nullptr, scr, F.lane); continue; } r -= I_NA;
        if (r < I_MLA) { const int nblk = DM / 32, kb = r / nblk, nb = r % nblk; p0_transpose_item(F.in[15], DM, 32 * nb, 64 * kb, (bf16_t*)(F.ws + WS_BMLA), 32 * nb, NAW, nullptr, scr, F.lane); continue; } r -= I_MLA;
        if (r < I_OUT) { const int nblk = DM / 32, kb = r / nblk, nb = r % nblk; p0_transpose_item(F.in[16], DM, 32 * nb, 64 * kb, (bf16_t*)(F.ws + WS_BOUT), 32 * nb, DM, nullptr, scr, F.lane); continue; } r -= I_OUT;
        if (r < I_FFN) { const int nblk = 2 * DFF / 32, kb = r / nblk, nb = r % nblk; const int n0 = 32 * nb, fch = n0 < DFF ? n0 : n0 - DFF, drow = 256 * (fch >> 7) + (n0 < DFF ? 0 : 128) + (fch & 127);
            p0_transpose_item(F.in[19], 2 * DFF, n0, 64 * kb, (bf16_t*)(F.ws + WS_BFFN), drow, DM, nullptr, scr, F.lane); continue; } r -= I_FFN;
        { const int nblk = DM / 32, kb = r / nblk, nb = r % nblk; p0_transpose_item(F.in[22], DM, 32 * nb, 64 * kb, (bf16_t*)(F.ws + WS_BDOWN), 32 * nb, DFF, nullptr, scr, F.lane); }
    }
}
__device__ __forceinline__ void p0_tables(Frame& F) {
    float* tc = (float*)(F.ws + WS_TBLC); float* ts = (float*)(F.ws + WS_TBLS);
    const int gt = F.vcu * 512 + F.tid, NT = F.G * 512;
    for (int idx = gt; idx < LS * 32; idx += NT) {
        const int pos = idx >> 5, i = idx & 31;
        double inv = 1.0; const double rr = 0.74989420933245582730;
        for (int q = 0; q < i; ++q) inv *= rr;
        const double ang = (double)pos * inv;
        const double TWO_PI = 6.283185307179586476925, n = __builtin_rint(ang / TWO_PI);
        double r = ang - n * TWO_PI;
        const double x = r * 0.25, x2 = x * x;
        double s = x * (1.0 + x2 * (-1.0 / 6 + x2 * (1.0 / 120 + x2 * (-1.0 / 5040 + x2 * (1.0 / 362880 + x2 * (-1.0 / 39916800 + x2 * (1.0 / 6227020800.0)))))));
        double c = 1.0 + x2 * (-0.5 + x2 * (1.0 / 24 + x2 * (-1.0 / 720 + x2 * (1.0 / 40320 + x2 * (-1.0 / 3628800 + x2 * (1.0 / 479001600.0 + x2 * (-1.0 / 87178291200.0)))))));
        double s2 = 2.0 * s * c, c2 = 1.0 - 2.0 * s * s;
        double s4 = 2.0 * s2 * c2, c4 = 1.0 - 2.0 * s2 * s2;
        tc[idx] = (float)c4; ts[idx] = (float)s4;
    }
}
__device__ __forceinline__ void t1_norm(Frame& F) {
    const int gw = F.vcu * NWAVES + F.wave, NGW = F.G * NWAVES;
    const float* mod = (const float*)(F.ws + WS_MOD); const float* g = F.in[6]; bf16_t* H = (bf16_t*)(F.ws + WS_H);
    for (int mp = gw; mp < MTOK / 2; mp += NGW) {
        int lane = F.lane; asm volatile("" : "+v"(lane));
        const int m = 2 * mp;
        const f32x4* xr = (const f32x4*)xrow(F, m) + lane; const float* md = mod + (size_t)seq_of(m) * NMOD;
        f32x4 v[16], u[16]; float s = 0.f, t = 0.f;
#pragma unroll
        for (int j = 0; j < 16; ++j) { v[j] = xr[64 * j]; u[j] = xr[64 * j + DM / 4];
            s += (v[j].x * v[j].x + v[j].y * v[j].y) + (v[j].z * v[j].z + v[j].w * v[j].w); t += (u[j].x * u[j].x + u[j].y * u[j].y) + (u[j].z * u[j].z + u[j].w * u[j].w); }
        const float rs0 = 1.0f / sqrtf(wave_sum(s) * (1.f / DM) + EPS), rs1 = 1.0f / sqrtf(wave_sum(t) * (1.f / DM) + EPS);
        u32x2* o8 = (u32x2*)(H + (size_t)m * DM) + lane;
#pragma unroll
        for (int j = 0; j < 16; ++j) { const int c0 = 4 * (lane + 64 * j);
            const f32x4 gg = *(const f32x4*)(g + c0), sh = *(const f32x4*)(md + c0), scl = *(const f32x4*)(md + DM + c0);
            const f32x4 a = gg * (scl + 1.0f);
            const f32x4 h0 = v[j] * rs0 * a + sh, h1 = u[j] * rs1 * a + sh;
            u32x2 w0, w1; w0.x = cvt_pk_bf16(h0.x, h0.y); w0.y = cvt_pk_bf16(h0.z, h0.w); w1.x = cvt_pk_bf16(h1.x, h1.y); w1.y = cvt_pk_bf16(h1.z, h1.w);
            o8[64 * j] = w0; o8[64 * j + DM / 4] = w1; }
    }
}
constexpr int NA_VROW = 976;
__device__ __forceinline__ bool na_decode(const Frame& F, int it, int& band, int& n, int& h) {
    int idx, x;
    if (F.G == 256) { x = F.vcu >> 5; idx = it * 32 + (F.vcu & 31); if (it >= 12) return false; h = 2 * x + (idx & 1); n = (idx >> 1) & 3; band = idx >> 3; return true; }
    const int gid = F.vcu + F.G * it; if (gid >= 48 * 4 * 16) return false; h = gid & 15; n = (gid >> 4) & 3; band = gid >> 6; return true;
}
__device__ __forceinline__ void na_bandinfo(int band, int& seqbase, int& rows, int& r0, int& kr0) {
    if (band < 16) { seqbase = (band >> 2) * LP; rows = 32; r0 = (band & 3) * 8; } else { seqbase = MP; rows = 256; r0 = (band - 16) * 8; }
    kr0 = r0 - 4; kr0 = kr0 < 0 ? 0 : kr0; kr0 = kr0 > rows - 8 ? rows - 8 : kr0;
}
__device__ __forceinline__ void t3a_na(Frame& F) {
    const bf16_t* QNA = (const bf16_t*)(F.ws + WS_QNA); const bf16_t* KNA = (const bf16_t*)(F.ws + WS_KNA); const bf16_t* VT = (const bf16_t*)(F.ws + WS_VT);
    bf16_t* ONA = (bf16_t*)(F.ws + WS_ONA); const float* rpb = F.in[9];
    const int w = F.wave;
    int tid = F.tid;
#define NA_LANE_STATE() asm volatile("" : "+v"(tid)); const int lane = tid & 63, g = lane >> 4, ql = lane & 15; \
    const int kwr = (tid >> 4) * 256 + (((tid & 15) ^ ((tid >> 4) & 15)) << 4);        \
    const int vwr = (tid >> 2) * NA_VROW + (tid & 3) * 16;
    LAS float* btab = (LAS float*)(F.lds + 136192);
    int band, n, h, seqbase, rows, r0, kr0;
    bool have = na_decode(F, 0, band, n, h);
    u32x4 kst[15], vst[15];
    if (have) { na_bandinfo(band, seqbase, rows, r0, kr0);
        const int kstart = (n == 0) ? 0 : (n == 1 ? 8 : (n == 2 ? 24 : 32));
#pragma unroll
        for (int j = 0; j < 15; ++j) { int kr = kr0 + j; kr = kr > rows - 1 ? rows - 1 : kr;
            kst[j] = *(const u32x4*)(KNA + (size_t)(seqbase + kr * 64 + kstart + (tid >> 4)) * NAW + h * HD + (tid & 15) * 8); } }
    for (int it = 0; have; ++it) {
        NA_LANE_STATE();
        const int kstart = (n == 0) ? 0 : (n == 1 ? 8 : (n == 2 ? 24 : 32));
        const int r = r0 + w; int start = r - 4; start = start < 0 ? 0 : start; start = start > rows - 8 ? rows - 8 : start;
        const int wstart = start - kr0;
        const int qc = 16 * n + ql; int cstart = qc - 8; cstart = cstart < 0 ? 0 : cstart; cstart = cstart > 48 ? 48 : cstart;
#pragma unroll
        for (int j = 0; j < 15; ++j) *(LAS u32x4*)(F.lds + kwr + j * 8192) = kst[j];
        if (tid < 465) btab[tid] = rpb[h * 465 + tid] * LOG2E;
        __syncthreads();
#pragma unroll
        for (int j = 0; j < 8; ++j) { int kr = kr0 + j; kr = kr > rows - 1 ? rows - 1 : kr;
            vst[j] = *(const u32x4*)(VT + (size_t)(h * HD + (tid >> 2)) * MTOK + seqbase + kr * 64 + kstart + (tid & 3) * 8); }
        const int qtok = seqbase + r * 64 + qc;
        bf16x8 qf[4];
#pragma unroll
        for (int ds = 0; ds < 4; ++ds) qf[ds] = *(const bf16x8*)(QNA + (size_t)qtok * NAW + h * HD + ds * 32 + 8 * g);
        f32x4 s[16];
        { const int kbase = (wstart * 32 + ql) * 256;
#pragma unroll
          for (int kb = 0; kb < 16; ++kb) { const int i = kb >> 1, jh = kb & 1; f32x4 a = {0.f, 0.f, 0.f, 0.f};
#pragma unroll
            for (int ds = 0; ds < 4; ++ds) { const bf16x8 kf = *(const LAS bf16x8*)(F.lds + kbase + (i * 32 + 16 * jh) * 256 + (((ds * 4 + g) ^ ql) << 4));
                a = __builtin_amdgcn_mfma_f32_16x16x32_bf16(kf, qf[ds], a, 0, 0, 0); }
            s[kb] = a; if ((kb & 1) == 1) asm volatile("" ::: "memory"); } }
#pragma unroll
        for (int j = 8; j < 15; ++j) { int kr = kr0 + j; kr = kr > rows - 1 ? rows - 1 : kr;
            vst[j] = *(const u32x4*)(VT + (size_t)(h * HD + (tid >> 2)) * MTOK + seqbase + kr * 64 + kstart + (tid & 3) * 8); }
        float mx = -1e30f;
#pragma unroll
        for (int kb = 0; kb < 16; ++kb) { const int i = kb >> 1, jh = kb & 1; const LAS float* bp = btab + (start + i - r + 7) * 31;
#pragma unroll
            for (int t = 0; t < 4; ++t) { const int kc = kstart + 16 * jh + 4 * g + t; const bool valid = (kc >= cstart) && (kc < cstart + 16);
                int dc = kc - qc + 15; dc = dc < 0 ? 0 : (dc > 30 ? 30 : dc);
                float b = bp[dc]; asm volatile("" : "+v"(b));
                const float v = valid ? s[kb][t] + b : -1e30f; s[kb][t] = v; mx = fmaxf(mx, v); }
            if ((kb & 3) == 3) asm volatile("" ::: "memory"); }
        mx = fmaxf(mx, __shfl_xor(mx, 16)); mx = fmaxf(mx, __shfl_xor(mx, 32));
        float sum = 0.f;
#pragma unroll
        for (int kb = 0; kb < 16; ++kb)
#pragma unroll
            for (int t = 0; t < 4; ++t) { const float p = __builtin_amdgcn_exp2f(s[kb][t] - mx); s[kb][t] = p; sum += p; }
        sum += __shfl_xor(sum, 16); sum += __shfl_xor(sum, 32);
        const float rinv = 1.0f / sum;
        bf16x8 pb[8];
#pragma unroll
        for (int i = 0; i < 8; ++i) { u32x4 wv; wv.x = cvt_pk_bf16(s[2 * i][0], s[2 * i][1]); wv.y = cvt_pk_bf16(s[2 * i][2], s[2 * i][3]); wv.z = cvt_pk_bf16(s[2 * i + 1][0], s[2 * i + 1][1]); wv.w = cvt_pk_bf16(s[2 * i + 1][2], s[2 * i + 1][3]);
            pb[i] = *reinterpret_cast<bf16x8*>(&wv); }
        __syncthreads();
#pragma unroll
        for (int j = 0; j < 15; ++j) *(LAS u32x4*)(F.lds + vwr + j * 64) = vst[j];
        __syncthreads();
        const int o_qtok = qtok, o_h = h;
        have = na_decode(F, it + 1, band, n, h);
        if (have) { na_bandinfo(band, seqbase, rows, r0, kr0);
            const int kstart2 = (n == 0) ? 0 : (n == 1 ? 8 : (n == 2 ? 24 : 32));
#pragma unroll
            for (int j = 0; j < 15; ++j) { int kr = kr0 + j; kr = kr > rows - 1 ? rows - 1 : kr;
                kst[j] = *(const u32x4*)(KNA + (size_t)(seqbase + kr * 64 + kstart2 + (tid >> 4)) * NAW + h * HD + (tid & 15) * 8); } }
        bf16_t* op = ONA + (size_t)o_qtok * NAW + o_h * HD + 4 * g;
#pragma unroll
        for (int db = 0; db < 8; ++db) { f32x4 o = {0.f, 0.f, 0.f, 0.f};
            const int vb = (16 * db + ql) * NA_VROW + wstart * 64 + 8 * g;
#pragma unroll
            for (int i = 0; i < 8; ++i) { const u32x2 lo = *(const LAS u32x2*)(F.lds + vb + i * 64), hi2 = *(const LAS u32x2*)(F.lds + vb + i * 64 + 32);
                u32x4 wv; wv.x = lo.x; wv.y = lo.y; wv.z = hi2.x; wv.w = hi2.y;
                o = __builtin_amdgcn_mfma_f32_16x16x32_bf16(*reinterpret_cast<bf16x8*>(&wv), pb[i], o, 0, 0, 0); }
            u32x2 wo; wo.x = cvt_pk_bf16(o[0] * rinv, o[1] * rinv); wo.y = cvt_pk_bf16(o[2] * rinv, o[3] * rinv); *(u32x2*)(op + 16 * db) = wo;
            asm volatile("" ::: "memory"); }
        __syncthreads();
    }
#undef NA_LANE_STATE
}
__device__ __forceinline__ void t3a_phase(Frame& F) {
    const int gw = F.vcu * NWAVES + F.wave, NGW = F.G * NWAVES;
    t3a_na(F);
    const bf16_t* QD = (const bf16_t*)(F.ws + WS_QD); const bf16_t* KVD = (const bf16_t*)(F.ws + WS_KVD);
    float* rsq = (float*)(F.ws + WS_RSQ); float* rskv = (float*)(F.ws + WS_RSKV); bf16_t* KPE = (bf16_t*)(F.ws + WS_KPE);
    const float* tc = (const float*)(F.ws + WS_TBLC); const float* ts = (const float*)(F.ws + WS_TBLS);
    for (int m = gw; m < MTOK; m += NGW) {
        const u32x4* qp = (const u32x4*)(QD + (size_t)m * 1024) + 2 * F.lane;
        float sq = 0.f;
        if (F.lane < 56) { const u32x4 a = qp[0], b = qp[1]; const unsigned w[8] = {a.x, a.y, a.z, a.w, b.x, b.y, b.z, b.w};
#pragma unroll
            for (int e = 0; e < 8; ++e) { const float lo = bflo(w[e]), hi = bfhi(w[e]); sq += lo * lo + hi * hi; } }
        sq = wave_sum(sq);
        const u32x4 kv = *((const u32x4*)(KVD + (size_t)m * 512) + F.lane); float sk = 0.f;
        { const unsigned w[4] = {kv.x, kv.y, kv.z, kv.w};
#pragma unroll
          for (int e = 0; e < 4; ++e) { const float lo = bflo(w[e]), hi = bfhi(w[e]); sk += lo * lo + hi * hi; } }
        sk = wave_sum(sk);
        if (F.lane == 0) { rsq[m] = 1.0f / sqrtf(sq * (1.f / QLORA) + EPS); rskv[m] = 1.0f / sqrtf(sk * (1.f / KVLORA) + EPS); }
        if (F.lane < 32) { const int pos = pos_of(m); const float c = tc[pos * 32 + F.lane], s = ts[pos * 32 + F.lane];
            const float x1 = bf2f(QD[(size_t)m * 1024 + 896 + F.lane]), x2 = bf2f(QD[(size_t)m * 1024 + 928 + F.lane]);
            KPE[(size_t)m * 64 + F.lane] = (bf16_t)(cvt_pk_bf16(x1 * c - x2 * s, 0.f) & 0xffffu);
            KPE[(size_t)m * 64 + 32 + F.lane] = (bf16_t)(cvt_pk_bf16(x1 * s + x2 * c, 0.f) & 0xffffu); }
    }
}
__device__ __forceinline__ void t4_phase(Frame& F) {
    const bf16_t* QM = (const bf16_t*)(F.ws + WS_QM); const bf16_t* KN = (const bf16_t*)(F.ws + WS_KNOPE); const bf16_t* KPE = (const bf16_t*)(F.ws + WS_KPE);
    const bf16_t* VM = (const bf16_t*)(F.ws + WS_VM); bf16_t* OM = (bf16_t*)(F.ws + WS_OMLA);
    const float* tc = (const float*)(F.ws + WS_TBLC); const float* ts = (const float*)(F.ws + WS_TBLS);
    for (int u = F.vcu; u < 1536; u += F.G) {
        int seqbase, seq, h, qb;
        if (u < 1024) { seqbase = MP; seq = LS; h = u >> 6; qb = u & 63; }
        else { const int v = u - 1024; seqbase = (v >> 7) * LP; seq = LP; h = (v >> 3) & 15; qb = v & 7; }
        const int m0 = seqbase + qb * 256;
        mla::attn_body2(QM + (size_t)m0 * 3072 + h * DQK, KN + (size_t)seqbase * 2048 + h * HD, KPE + (size_t)seqbase * 64, VM + (size_t)seqbase * 2048 + h * HD,
                       OM + (size_t)m0 * 2048 + h * HD, seq, qb * 256, tc, ts, F.ldsg, F.wave);
    }
}
__device__ __forceinline__ void t7_norm(Frame& F) {
    const int gw = F.vcu * NWAVES + F.wave, NGW = F.G * NWAVES;
    const float* mod = (const float*)(F.ws + WS_MOD); const float* gpost = F.in[7]; const float* gpre = F.in[17];
    const bf16_t* Y1 = (const bf16_t*)(F.ws + WS_Y1); bf16_t* H = (bf16_t*)(F.ws + WS_H);
    for (int m = gw; m < MTOK; m += NGW) {
        int lane = F.lane; asm volatile("" : "+v"(lane));
        const float* xr = xrow(F, m); const float* md = mod + (size_t)seq_of(m) * NMOD; float* orow = F.out + (size_t)m * DM;
        const u32x4* yp = (const u32x4*)(Y1 + (size_t)m * DM) + lane;
        f32x4 v[16]; float s = 0.f;
#pragma unroll
        for (int j = 0; j < 8; ++j) { const u32x4 w = yp[64 * j];
            v[2 * j] = (f32x4){bflo(w.x), bfhi(w.x), bflo(w.y), bfhi(w.y)}; v[2 * j + 1] = (f32x4){bflo(w.z), bfhi(w.z), bflo(w.w), bfhi(w.w)};
            s += (v[2 * j].x * v[2 * j].x + v[2 * j].y * v[2 * j].y) + (v[2 * j].z * v[2 * j].z + v[2 * j].w * v[2 * j].w);
            s += (v[2 * j + 1].x * v[2 * j + 1].x + v[2 * j + 1].y * v[2 * j + 1].y) + (v[2 * j + 1].z * v[2 * j + 1].z + v[2 * j + 1].w * v[2 * j + 1].w); }
        const float rstd = 1.0f / sqrtf(wave_sum(s) * (1.f / DM) + EPS);
        float s2 = 0.f;
#pragma unroll
        for (int j = 0; j < 8; ++j) { const int c0 = 8 * (lane + 64 * j);
#pragma unroll
            for (int q = 0; q < 2; ++q) { const int c = c0 + 4 * q;
                const f32x4 x = *(const f32x4*)(xr + c), gg = *(const f32x4*)(gpost + c), gt = *(const f32x4*)(md + 2 * DM + c);
                const f32x4 x1 = x + gt * (v[2 * j + q] * rstd * gg);
                *(f32x4*)(orow + c) = x1; v[2 * j + q] = x1;
                s2 += (x1.x * x1.x + x1.y * x1.y) + (x1.z * x1.z + x1.w * x1.w); } }
        const float rstd2 = 1.0f / sqrtf(wave_sum(s2) * (1.f / DM) + EPS);
        u32x4* hp = (u32x4*)(H + (size_t)m * DM) + lane;
#pragma unroll
        for (int j = 0; j < 8; ++j) { const int c0 = 8 * (lane + 64 * j); f32x4 hh[2];
#pragma unroll
            for (int q = 0; q < 2; ++q) { const int c = c0 + 4 * q;
                const f32x4 gg = *(const f32x4*)(gpre + c), sh = *(const f32x4*)(md + 3 * DM + c), scl = *(const f32x4*)(md + 4 * DM + c);
                hh[q] = v[2 * j + q] * rstd2 * gg * (scl + 1.0f) + sh; }
            hp[64 * j] = pg8::pack8(hh[0], hh[1]); }
    }
}
__device__ __forceinline__ void t9_fixup(Frame& F) {
    const int gt = F.vcu * 512 + F.tid, NT = F.G * 512;
    bf16_t* G = (bf16_t*)(F.ws + WS_G); const float* side = (const float*)(F.ws + WS_SIDE); const float* cw = F.in[20];
    constexpr int SN = pg8::SIDE_N;
    for (int idx = gt; idx < 96 * (DFF / 4); idx += NT) {
        const int pm = idx / (DFF / 4), f = (idx % (DFF / 4)) * 4;
        const bool seq_start = (pm <= 32) && ((pm & 7) == 0), seq_end = (pm < 32 && (pm & 7) == 7) || pm == 95;
        const size_t o = (size_t)pm * DFF + f;
        { f32x4 pre = *(const f32x4*)(side + o); const f32x4 uu = *(const f32x4*)(side + 4 * SN + o);
          if (!seq_start) { const f32x4 al = *(const f32x4*)(side + 3 * SN + o - DFF), w = *(const f32x4*)(cw + f); pre = pre + w * al; }
          u32x2 w2; w2.x = cvt_pk_bf16(pg8::gelu_tanh_f(pre.x) * uu.x, pg8::gelu_tanh_f(pre.y) * uu.y); w2.y = cvt_pk_bf16(pg8::gelu_tanh_f(pre.z) * uu.z, pg8::gelu_tanh_f(pre.w) * uu.w);
          *(u32x2*)(G + (size_t)(pm * 256) * DFF + f) = w2; }
        { f32x4 pre = *(const f32x4*)(side + SN + o); const f32x4 uu = *(const f32x4*)(side + 5 * SN + o);
          if (!seq_end) { const f32x4 af = *(const f32x4*)(side + 2 * SN + o + DFF), w = *(const f32x4*)(cw + 2 * DFF + f); pre = pre + w * af; }
          u32x2 w2; w2.x = cvt_pk_bf16(pg8::gelu_tanh_f(pre.x) * uu.x, pg8::gelu_tanh_f(pre.y) * uu.y); w2.y = cvt_pk_bf16(pg8::gelu_tanh_f(pre.z) * uu.z, pg8::gelu_tanh_f(pre.w) * uu.w);
          *(u32x2*)(G + (size_t)(pm * 256 + 255) * DFF + f) = w2; }
    }
}
__device__ __forceinline__ void t11_final(Frame& F) {
    const int gw = F.vcu * NWAVES + F.wave, NGW = F.G * NWAVES;
    const float* mod = (const float*)(F.ws + WS_MOD); const float* gpost = F.in[18]; const bf16_t* Fb = (const bf16_t*)(F.ws + WS_F);
    for (int mp = gw; mp < MTOK / 2; mp += NGW) {
        int lane = F.lane; asm volatile("" : "+v"(lane));
        const int m = 2 * mp;
        const float* md = mod + (size_t)seq_of(m) * NMOD; float* orow = F.out + (size_t)m * DM;
        const u32x4* yp = (const u32x4*)(Fb + (size_t)m * DM) + lane;
        f32x4 v[2][16]; float s[2] = {0.f, 0.f};
#pragma unroll
        for (int rr = 0; rr < 2; ++rr)
#pragma unroll
            for (int j = 0; j < 8; ++j) { const u32x4 w = yp[64 * j + rr * (DM / 8)];
                v[rr][2 * j] = (f32x4){bflo(w.x), bfhi(w.x), bflo(w.y), bfhi(w.y)}; v[rr][2 * j + 1] = (f32x4){bflo(w.z), bfhi(w.z), bflo(w.w), bfhi(w.w)};
                const f32x4 a = v[rr][2 * j], b = v[rr][2 * j + 1];
                s[rr] += ((a.x * a.x + a.y * a.y) + (a.z * a.z + a.w * a.w)) + ((b.x * b.x + b.y * b.y) + (b.z * b.z + b.w * b.w)); }
        const float rstd[2] = {1.0f / sqrtf(wave_sum(s[0]) * (1.f / DM) + EPS), 1.0f / sqrtf(wave_sum(s[1]) * (1.f / DM) + EPS)};
#pragma unroll
        for (int j = 0; j < 8; ++j) { const int c0 = 8 * (lane + 64 * j);
#pragma unroll
            for (int q = 0; q < 2; ++q) { const int c = c0 + 4 * q;
                const f32x4 gg = *(const f32x4*)(gpost + c), gt = *(const f32x4*)(md + 5 * DM + c); const f32x4 a = gt * gg;
#pragma unroll
                for (int rr = 0; rr < 2; ++rr) { const f32x4 x1 = *(const f32x4*)(orow + rr * DM + c);
                    *(f32x4*)(orow + rr * DM + c) = x1 + a * (v[rr][2 * j + q] * rstd[rr]); } } }
    }
}

constexpr int NPHASE = 13;
struct Args { const float* in[23]; float* out; unsigned char* ws; int ph_lo, ph_hi; };
__global__ void __launch_bounds__(NWAVES * 64, 2) fwd_kernel(Args args) {
    extern __shared__ __attribute__((aligned(16))) unsigned char lds[];
    Frame F;
    F.lds = (LAS unsigned char*)lds; F.ldsg = (char*)lds;
    F.MISC = (volatile LAS unsigned*)(F.lds + MISC_OFF);
    F.tid = threadIdx.x; F.lane = F.tid & 63; F.wave = __builtin_amdgcn_readfirstlane(F.tid >> 6);
    F.G = gridDim.x; { const int bx = blockIdx.x; F.vcu = (F.G % 8 == 0) ? (bx % 8) * (F.G / 8) + bx / 8 : bx; }
#pragma unroll
    for (int i = 0; i < 23; ++i) F.in[i] = args.in[i];
    F.out = args.out; F.ws = args.ws; F.ctl = (unsigned*)(args.ws + WS_CTL);
    for (int u = F.tid; u < (LDS_BYTES - LDSCTL_OFF) / 4; u += NWAVES * 64) ((LAS unsigned*)(F.lds + LDSCTL_OFF))[u] = 0u;
    __syncthreads();
    XcdBarrier bar; bar.bar = F.ctl + CW_BAR; bar.x = 0; bar.st = nullptr; bar.wave = 0;
    if (MK_N_LAUNCHES == 1) bar = xcd_barrier_post(F.ctl + CW_BAR, F.MISC + 8, F.wave);
    const int lo = args.ph_lo, hi = args.ph_hi;
#ifndef PHASE_MASK
#define PHASE_MASK 0xffff
#endif
#define IN(k) (((PHASE_MASK >> (k)) & 1) && lo <= (k) && (k) < hi)
#ifndef DUP_MASK
#define DUP_MASK 0
#endif
#define FRESH() do { F.lane = fresh_lane(); F.tid = F.wave * 64 + F.lane; } while (0)
#define REP(k) for (int rep_ = 0; rep_ < (((DUP_MASK >> (k)) & 1) ? 2 : 1); ++rep_)
#define SEAM(k) do { if (IN(k) && IN((k) + 1)) xcd_barrier(bar); } while (0)
    unsigned char* ws = F.ws;
    const int bx = (int)blockIdx.x;

    if (IN(0)) REP(0) { FRESH(); p0_mod(F); p0_weights(F); p0_tables(F); }
    SEAM(0);
    if (IN(1)) REP(1) { FRESH(); t1_norm(F); }
    SEAM(1);
    if (IN(2)) REP(2) { FRESH();
        { pg8::Gemm g{(const bf16_t*)(ws + WS_H), (const bf16_t*)(ws + WS_BIN), MTOK, ZN1, DM, DM, DM}; pg8::StaticOrder S; S.init(MTOK, ZN1, F.G, bx);
          pg8::EpiZ E{(bf16_t*)(ws + WS_QNA), (bf16_t*)(ws + WS_KNA), (bf16_t*)(ws + WS_QD), (bf16_t*)(ws + WS_KVD), (bf16_t*)F.out, (bf16_t*)F.out + (size_t)MTOK * DM};
          pg8::gemm_phase<pg8::EpiZ, pg8::StaticOrder>(F.lds, g, S, E, F.wave); }
        { pg8::Gemm g{(const bf16_t*)(ws + WS_BIN) + (size_t)ZN1 * DM, (const bf16_t*)(ws + WS_H), NAW, MTOK, DM, DM, DM}; pg8::StaticOrder S; S.init(NAW, MTOK, F.G, bx);
          pg8::EpiPlain E{(bf16_t*)(ws + WS_VT), MTOK};
          pg8::gemm_phase<pg8::EpiPlain, pg8::StaticOrder>(F.lds, g, S, E, F.wave); }
    }
    SEAM(2);
    if (IN(3)) REP(3) { FRESH(); t3a_phase(F); }
    SEAM(3);
    if (IN(4)) REP(4) { FRESH();
        { pg8::Gemm g{(const bf16_t*)(ws + WS_QD), (const bf16_t*)(ws + WS_BUQ), MTOK, 3072, QLORA, 1024, QLORA}; pg8::StaticOrder S; S.init(MTOK, 3072, F.G, bx);
          pg8::EpiUQ E{(bf16_t*)(ws + WS_QM), (const float*)(ws + WS_RSQ)};
          pg8::gemm_phase<pg8::EpiUQ, pg8::StaticOrder>(F.lds, g, S, E, F.wave); }
        { pg8::Gemm g{(const bf16_t*)(ws + WS_KVD), (const bf16_t*)(ws + WS_BUKV), MTOK, 4096, KVLORA, KVLORA, KVLORA}; pg8::StaticOrder S; S.init(MTOK, 4096, F.G, bx);
          pg8::EpiUKV E{(bf16_t*)(ws + WS_KNOPE), (bf16_t*)(ws + WS_VM), (const float*)(ws + WS_RSKV)};
          pg8::gemm_phase<pg8::EpiUKV, pg8::StaticOrder>(F.lds, g, S, E, F.wave); }
    }
    SEAM(4);
    if (IN(5)) REP(5) { FRESH(); t4_phase(F); }
    SEAM(5);
    if (IN(6)) REP(6) { FRESH();
        { pg8::Gemm g{(const bf16_t*)(ws + WS_ONA), (const bf16_t*)(ws + WS_BNA), MTOK, DM, NAW, NAW, NAW, (const bf16_t*)(ws + WS_OMLA), (const bf16_t*)(ws + WS_BMLA)}; pg8::DualOrder S; S.init(MTOK, DM, F.G, bx);
          pg8::EpiMergeDual E{(bf16_t*)(ws + WS_T), (const bf16_t*)F.out, (const bf16_t*)F.out + (size_t)MTOK * DM};
          pg8::gemm_phase<pg8::EpiMergeDual, pg8::DualOrder>(F.lds, g, S, E, F.wave); }
    }
    SEAM(6);
    if (IN(7)) REP(7) { FRESH();
        pg8::Gemm g{(const bf16_t*)(ws + WS_T), (const bf16_t*)(ws + WS_BOUT), MTOK, DM, DM, DM, DM}; pg8::StaticOrder S; S.init(MTOK, DM, F.G, bx);
        pg8::EpiPlain E{(bf16_t*)(ws + WS_Y1), DM};
        pg8::gemm_phase<pg8::EpiPlain, pg8::StaticOrder>(F.lds, g, S, E, F.wave);
    }
    SEAM(7);
    if (IN(8)) REP(8) { FRESH(); t7_norm(F); }
    SEAM(8);
    if (IN(9)) REP(9) { FRESH();
        pg8::Gemm g{(const bf16_t*)(ws + WS_H), (const bf16_t*)(ws + WS_BFFN), MTOK, 2 * DFF, DM, DM, DM}; pg8::StaticOrder S; S.init(MTOK, 2 * DFF, F.G, bx);
        pg8::EpiFFNConv E{(bf16_t*)(ws + WS_G), (float*)(ws + WS_SIDE), F.in[20], F.in[21], (LAS float*)(F.lds + RING_BYTES)};
        pg8::gemm_phase<pg8::EpiFFNConv, pg8::StaticOrder>(F.lds, g, S, E, F.wave);
    }
    SEAM(9);
    if (IN(10)) REP(10) { FRESH(); t9_fixup(F); }
    SEAM(10);
    if (IN(11)) REP(11) { FRESH();
        pg8::Gemm g{(const bf16_t*)(ws + WS_G), (const bf16_t*)(ws + WS_BDOWN), MTOK, DM, DFF, DFF, DFF}; pg8::StaticOrder S; S.init(MTOK, DM, F.G, bx);
        pg8::EpiPlain E{(bf16_t*)(ws + WS_F), DM};
        pg8::gemm_phase<pg8::EpiPlain, pg8::StaticOrder>(F.lds, g, S, E, F.wave);
    }
    SEAM(11);
    if (IN(12)) REP(12) { FRESH(); t11_final(F); }
#undef IN
#undef SEAM
}

extern "C" void kernel_launch(void* const* d_in, const int* in_sizes, int n_in, void* d_out, int out_size, void* d_ws, size_t ws_size, hipStream_t stream) {
    static int grid = 0;
    if (grid == 0) {
        if (n_in != 23 || out_size != MTOK * DM || ws_size < WS_END) { fprintf(stderr, "kernel_launch: unexpected shapes (n_in %d, out %d, ws %zu; need ws >= %zu)\n", n_in, out_size, ws_size, (size_t)WS_END); grid = -1; return; }
        int dev = 0, cus = 0, per_cu = 0;
        if (hipGetDevice(&dev) != hipSuccess || hipDeviceGetAttribute(&cus, hipDeviceAttributeMultiprocessorCount, dev) != hipSuccess) { grid = -1; return; }
        if (hipFuncSetAttribute((const void*)fwd_kernel, hipFuncAttributeMaxDynamicSharedMemorySize, LDS_BYTES) != hipSuccess) { fprintf(stderr, "kernel_launch: hipFuncSetAttribute failed\n"); grid = -1; return; }
        if (hipOccupancyMaxActiveBlocksPerMultiprocessor(&per_cu, (const void*)fwd_kernel, NWAVES * 64, LDS_BYTES) != hipSuccess || per_cu < 1) { fprintf(stderr, "kernel_launch: occupancy query says %d blocks per CU\n", per_cu); }
        (void)hipGetLastError();
        grid = cus;
    }
    if (grid < 0) return;
    (void)hipMemsetAsync((char*)d_ws + WS_CTL, 0, CTL_ZERO_BYTES, stream);
    Args a{};
    for (int i = 0; i < 23; ++i) a.in[i] = (const float*)d_in[i];
    a.out = (float*)d_out; a.ws = (unsigned char*)d_ws;
    if (MK_N_LAUNCHES == 1) { a.ph_lo = 0; a.ph_hi = NPHASE; hipLaunchKernelGGL(fwd_kernel, dim3(grid), dim3(NWAVES * 64), LDS_BYTES, stream, a); }
    else { for (int p = 0; p < NPHASE; ++p) { a.ph_lo = p; a.ph_hi = p + 1; hipLaunchKernelGGL(fwd_kernel, dim3(grid), dim3(NWAVES * 64), LDS_BYTES, stream, a); } }
    const hipError_t le = hipPeekAtLastError();
    if (le != hipSuccess) fprintf(stderr, "kernel_launch: launch failed: %s\n", hipGetErrorName(le));
}
```

```cpp
#include <hip/hip_runtime.h>
#include <cstdio>
#include <cstdint>

#ifndef MK_N_LAUNCHES
#define MK_N_LAUNCHES 1
#endif

#define LAS __attribute__((address_space(3)))
#define GAS __attribute__((address_space(1)))
typedef unsigned short bf16_t;
typedef short bf16x8 __attribute__((ext_vector_type(8)));
typedef short s16x4 __attribute__((ext_vector_type(4)));
typedef float f32x4 __attribute__((ext_vector_type(4)));
typedef float f32x2 __attribute__((ext_vector_type(2)));
typedef float f32x16 __attribute__((ext_vector_type(16)));
typedef unsigned u32x4 __attribute__((ext_vector_type(4)));
typedef unsigned u32x2 __attribute__((ext_vector_type(2)));

constexpr int DM = 4096, MTOK = 24576, MP = 8192, LP = 2048, LS = 16384;
constexpr int NH = 16, HD = 128, NAW = 2048;
constexpr int QLORA = 896, KVLORA = 512, ROPE = 64, DQK = 192;
constexpr int DFF = 11008, NMOD = 6 * DM;
constexpr int INW = 15808;
constexpr int ZN1 = 13824;
constexpr float EPS = 1e-6f;
constexpr float LOG2E = 1.4426950408889634f;

constexpr size_t MiB = 1u << 20;
constexpr size_t WS_CTL = 0, CTL_ZERO_BYTES = 1 * MiB;
constexpr size_t WS_MOD = 1 * MiB;
constexpr size_t WS_RSQ = 1 * MiB + 512 * 1024;
constexpr size_t WS_RSKV = WS_RSQ + 128 * 1024;
constexpr size_t WS_TBLC = 2 * MiB, WS_TBLS = 4 * MiB;
constexpr size_t WS_KPE = 6 * MiB;
constexpr size_t WS_BFFN = 10 * MiB;
constexpr size_t WS_BDOWN = 182 * MiB;
constexpr size_t WS_H = 268 * MiB;
constexpr size_t WS_ONA = WS_H, WS_OMLA = WS_H + 96 * MiB;
constexpr size_t WS_BIG = 460 * MiB;
constexpr size_t WS_BIN = WS_BIG;
constexpr size_t WS_BUQ = 584 * MiB;
constexpr size_t WS_BUKV = 590 * MiB;
constexpr size_t WS_BNA = 594 * MiB, WS_BMLA = 610 * MiB;
constexpr size_t WS_BOUT = 626 * MiB;
constexpr size_t WS_QNA = 658 * MiB, WS_KNA = 754 * MiB, WS_VT = 850 * MiB;
constexpr size_t WS_QD = 946 * MiB;
constexpr size_t WS_KVD = 994 * MiB;
constexpr size_t WS_QM = 1018 * MiB;
constexpr size_t WS_KNOPE = 1162 * MiB, WS_VM = 1258 * MiB;
constexpr size_t WS_T = WS_QNA;
constexpr size_t WS_Y1 = WS_QM;
constexpr size_t WS_G = WS_BIG;
constexpr size_t WS_SIDE = WS_BIG + 516 * MiB;
constexpr size_t WS_F = WS_H;
constexpr size_t WS_END = 1492 * MiB;
constexpr int CW_TMO = 0, CW_CODE = 1, CW_BAR = 4096;

constexpr int RING_BYTES = 131072;
constexpr int LDSCTL_OFF = 161792, MISC_OFF = LDSCTL_OFF + 320;
constexpr int LDS_BYTES = 163840;
constexpr int NWAVES = 8;

__device__ __forceinline__ unsigned cvt_pk_bf16(float lo, float hi) { unsigned r; asm volatile("v_cvt_pk_bf16_f32 %0, %1, %2" : "=v"(r) : "v"(lo), "v"(hi)); return r; }
__device__ __forceinline__ float bf2f(unsigned short b) { return __uint_as_float(((unsigned)b) << 16); }
__device__ __forceinline__ float bflo(unsigned w) { return __uint_as_float(w << 16); }
__device__ __forceinline__ float bfhi(unsigned w) { return __uint_as_float(w & 0xffff0000u); }
__device__ __forceinline__ float fast_sigmoid(float x) { return __builtin_amdgcn_rcpf(1.0f + __builtin_amdgcn_exp2f(-LOG2E * x)); }
__device__ __forceinline__ int fresh_lane() { unsigned z = 0; asm volatile("" : "+v"(z)); return (int)__builtin_amdgcn_mbcnt_hi(~0u, __builtin_amdgcn_mbcnt_lo(~0u, z)); }
#define LDS_WAIT() asm volatile("s_waitcnt lgkmcnt(0)" ::: "memory")
#define VM_WAIT() asm volatile("s_waitcnt vmcnt(0)" ::: "memory")

namespace pg8 {
constexpr int BM = 256, BK = 64, HALF = 128, HTB = HALF * BK * 2, STAGE_BYTES = 8 * HTB, NXCD = 8, WGM = 8;
__host__ __device__ __forceinline__ int lds_byte(int r, int c) { const int st = (r >> 4) * 2 + (c >> 5), rr = r & 15, cc = c & 31, ob = rr * 64 + cc * 2; return st * 1024 + (ob ^ (((ob >> 9) & 1) << 5)); }
__host__ __device__ __forceinline__ void stage_rc(int b, int& R, int& C) { const int st = b / 1024, sb = b % 1024, swz = sb ^ (((sb >> 9) & 1) << 5); R = (st >> 1) * 16 + swz / 64; C = (st & 1) * 32 + (swz % 64) / 2; }
__host__ __device__ __forceinline__ int perm32(int rho) { const int n = rho >> 4, i = rho & 15; return 8 * (i >> 2) + 4 * n + (i & 3); }

struct Unit { int pm, pn, sub; };
struct Gemm { const bf16_t* A; const bf16_t* Bt; int M, N, K, lda, ldb; const bf16_t* A2; const bf16_t* Bt2; };

struct StaticOrder {
    int nM, nN, nwg, G, c;
    __host__ __device__ void init(int M, int N, int G_, int c_) { nM = M / BM; nN = N / BM; nwg = nM * nN; G = G_; c = c_; }
    __host__ __device__ bool next(int i, Unit& u) const {
        const long L = (long)i * G + c; if (L >= nwg) return false;
        int wgid = (int)L; { const int q = nwg / NXCD, r = nwg % NXCD, xcd = wgid % NXCD, off = wgid / NXCD; wgid = (xcd < r ? xcd * (q + 1) : r * (q + 1) + (xcd - r) * q) + off; }
        const int nig = WGM * nN, gid = wgid / nig, fm = gid * WGM, gsz = (nM - fm) < WGM ? (nM - fm) : WGM;
        u.pm = fm + ((wgid % nig) % gsz); u.pn = (wgid % nig) / gsz; u.sub = 0; return true;
    }
    __device__ __forceinline__ void a_ready(const Unit&) const {}
    __device__ __forceinline__ void done(const Unit&) const {}
};

struct DualOrder : StaticOrder {
    __host__ __device__ bool next(int i, Unit& u) const { const bool ok = StaticOrder::next(i >> 1, u); u.sub = i & 1; return ok; }
};
typedef f32x4 Acc[2][2][4][2];
__device__ __forceinline__ u32x4 pack8(f32x4 v0, f32x4 v1) { u32x4 w; w.x = cvt_pk_bf16(v0[0], v0[1]); w.y = cvt_pk_bf16(v0[2], v0[3]); w.z = cvt_pk_bf16(v1[0], v1[1]); w.w = cvt_pk_bf16(v1[2], v1[3]); return w; }

struct EpiPlain {
    static constexpr bool PERM = true, AFTER_DRAIN = false;
    bf16_t* O; int ldc;
    __device__ __forceinline__ void operator()(const Acc& acc, const Unit& u, int wr, int wc, int fr, int fq) const {
        const int row0 = u.pm * BM + wr * 64 + fr, col0 = u.pn * BM + wc * 32 + 8 * fq;
#pragma unroll
        for (int ai = 0; ai < 2; ++ai)
#pragma unroll
            for (int m = 0; m < 4; ++m) { bf16_t* rowp = O + (size_t)(row0 + ai * HALF + m * 16) * ldc + col0;
#pragma unroll
                for (int bj = 0; bj < 2; ++bj) *(u32x4*)(rowp + bj * HALF) = pack8(acc[ai][bj][m][0], acc[ai][bj][m][1]); }
    }
};
struct EpiZ {
    static constexpr bool PERM = true, AFTER_DRAIN = false;
    bf16_t *qna, *kna, *qd, *kvd, *gna, *gmla;
    __device__ __forceinline__ void operator()(const Acc& acc, const Unit& u, int wr, int wc, int fr, int fq) const {
        const int pn = u.pn; bf16_t* base; int ldc, ct, mode = 0;
        if (pn < 8) { base = qna; ldc = 2048; ct = pn; mode = 1; }
        else if (pn < 16) { base = kna; ldc = 2048; ct = pn - 8; }
        else if (pn < 20) { base = qd; ldc = 1024; ct = pn - 16; }
        else if (pn < 22) { base = kvd; ldc = 512; ct = pn - 20; }
        else if (pn < 38) { base = gna; ldc = 4096; ct = pn - 22; mode = 2; }
        else { base = gmla; ldc = 4096; ct = pn - 38; mode = 2; }
        const int row0 = u.pm * BM + wr * 64 + fr, col0 = ct * BM + wc * 32 + 8 * fq;
        const float qs = 0.08838834764831845f * LOG2E;
#pragma unroll
        for (int ai = 0; ai < 2; ++ai)
#pragma unroll
            for (int m = 0; m < 4; ++m) { bf16_t* rowp = base + (size_t)(row0 + ai * HALF + m * 16) * ldc + col0;
#pragma unroll
                for (int bj = 0; bj < 2; ++bj) { f32x4 v0 = acc[ai][bj][m][0], v1 = acc[ai][bj][m][1];
                    if (mode == 1) { v0 = v0 * qs; v1 = v1 * qs; }
                    if (mode == 2) {
#pragma unroll
                        for (int j = 0; j < 4; ++j) { v0[j] = fast_sigmoid(v0[j]); v1[j] = fast_sigmoid(v1[j]); } }
                    *(u32x4*)(rowp + bj * HALF) = pack8(v0, v1); } }
    }
};
struct EpiUQ {
    static constexpr bool PERM = true, AFTER_DRAIN = false;
    bf16_t* qm; const float* rs;
    __device__ __forceinline__ void operator()(const Acc& acc, const Unit& u, int wr, int wc, int fr, int fq) const {
        const int row0 = u.pm * BM + wr * 64 + fr, col0 = u.pn * BM + wc * 32 + 8 * fq;
#pragma unroll
        for (int ai = 0; ai < 2; ++ai)
#pragma unroll
            for (int m = 0; m < 4; ++m) { const int row = row0 + ai * HALF + m * 16; const float s = rs[row]; bf16_t* rowp = qm + (size_t)row * 3072 + col0;
#pragma unroll
                for (int bj = 0; bj < 2; ++bj) *(u32x4*)(rowp + bj * HALF) = pack8(acc[ai][bj][m][0] * s, acc[ai][bj][m][1] * s); }
    }
};
struct EpiUKV {
    static constexpr bool PERM = true, AFTER_DRAIN = false;
    bf16_t *kn, *vm; const float* rs;
    __device__ __forceinline__ void operator()(const Acc& acc, const Unit& u, int wr, int wc, int fr, int fq) const {
        const int row0 = u.pm * BM + wr * 64 + fr, col0 = u.pn * HD + wc * 32 + 8 * fq;
#pragma unroll
        for (int ai = 0; ai < 2; ++ai)
#pragma unroll
            for (int m = 0; m < 4; ++m) { const int row = row0 + ai * HALF + m * 16; const float s = rs[row];
                *(u32x4*)(kn + (size_t)row * 2048 + col0) = pack8(acc[ai][0][m][0] * s, acc[ai][0][m][1] * s);
                *(u32x4*)(vm + (size_t)row * 2048 + col0) = pack8(acc[ai][1][m][0] * s, acc[ai][1][m][1] * s); }
    }
};
struct EpiMergeDual {
    static constexpr bool PERM = true, AFTER_DRAIN = false;
    bf16_t* T; const bf16_t* gna; const bf16_t* gmla;
    __device__ __forceinline__ void operator()(Acc& acc, const Unit& u, int wr, int wc, int fr, int fq) const {
        const int row0 = u.pm * BM + wr * 64 + fr, col0 = u.pn * BM + wc * 32 + 8 * fq; const float GMIN = 5.9604645e-8f;
#pragma unroll
        for (int ai = 0; ai < 2; ++ai)
#pragma unroll
            for (int m = 0; m < 4; ++m) { const size_t off = (size_t)(row0 + ai * HALF + m * 16) * 4096 + col0;
#pragma unroll
                for (int bj = 0; bj < 2; ++bj) { const u32x4 gm = *(const u32x4*)(gmla + off + bj * HALF);
                    float gmf[8] = {bflo(gm.x), bfhi(gm.x), bflo(gm.y), bfhi(gm.y), bflo(gm.z), bfhi(gm.z), bflo(gm.w), bfhi(gm.w)};
#pragma unroll
                    for (int e = 0; e < 8; ++e) gmf[e] = fmaxf(gmf[e], GMIN);
                    if (u.sub == 0) { const u32x4 gn = *(const u32x4*)(gna + off + bj * HALF);
                        const float gnf[8] = {bflo(gn.x), bfhi(gn.x), bflo(gn.y), bfhi(gn.y), bflo(gn.z), bfhi(gn.z), bflo(gn.w), bfhi(gn.w)};
#pragma unroll
                        for (int e = 0; e < 4; ++e) { acc[ai][bj][m][0][e] *= gnf[e] * __builtin_amdgcn_rcpf(gmf[e]); acc[ai][bj][m][1][e] *= gnf[4 + e] * __builtin_amdgcn_rcpf(gmf[4 + e]); } }
                    else { f32x4 v0 = acc[ai][bj][m][0], v1 = acc[ai][bj][m][1];
#pragma unroll
                        for (int e = 0; e < 4; ++e) { v0[e] *= gmf[e]; v1[e] *= gmf[4 + e]; }
                        *(u32x4*)(T + off + bj * HALF) = pack8(v0, v1); } } }
    }
};
__device__ __forceinline__ float gelu_tanh_f(float x) { const float z = 0.7978845608028654f * (x + 0.044715f * x * x * x); return x * fast_sigmoid(2.0f * z); }
constexpr int SIDE_N = 96 * DFF;
struct EpiFFNConv {
    static constexpr bool PERM = true, AFTER_DRAIN = false;
    bf16_t* G; float* side; const float* cw; const float* cb; LAS float* xch;
    __device__ __forceinline__ void operator()(const Acc& acc, const Unit& u, int wr, int wc, int fr, int fq) const {
        const int lane = fq * 16 + fr, cl0 = wc * 32 + 8 * fq, f0 = u.pn * 128 + cl0;
        LAS float* xf = xch; LAS float* xl = xch + 512;
#pragma unroll
        for (int ai = 0; ai < 2; ++ai) { const int blk = 2 * ai + wr;
#pragma unroll
            for (int n = 0; n < 2; ++n) { if (fr == 0) *(LAS f32x4*)(xf + blk * 128 + cl0 + 4 * n) = acc[ai][0][0][n]; if (fr == 15) *(LAS f32x4*)(xl + blk * 128 + cl0 + 4 * n) = acc[ai][0][3][n]; } }
        asm volatile("s_waitcnt lgkmcnt(0)" ::: "memory"); __builtin_amdgcn_s_barrier(); asm volatile("" ::: "memory");
        const int src_up = (lane & 48) | ((lane + 15) & 15), src_dn = (lane & 48) | ((lane + 1) & 15);
#define SHF4(dst, v, srcl) do { dst[0] = __shfl(v[0], srcl); dst[1] = __shfl(v[1], srcl); dst[2] = __shfl(v[2], srcl); dst[3] = __shfl(v[3], srcl); } while (0)
#pragma unroll
        for (int n = 0; n < 2; ++n) {
            const f32x4 w0 = *(const f32x4*)(cw + f0 + 4 * n), w1 = *(const f32x4*)(cw + DFF + f0 + 4 * n), w2 = *(const f32x4*)(cw + 2 * DFF + f0 + 4 * n), bb = *(const f32x4*)(cb + f0 + 4 * n);
#pragma unroll
            for (int ai = 0; ai < 2; ++ai) { const int blk = 2 * ai + wr;
                f32x4 rc_prev = blk > 0 ? *(const LAS f32x4*)(xl + (blk - 1) * 128 + cl0 + 4 * n) : (f32x4){0.f, 0.f, 0.f, 0.f};
                const f32x4 bot = blk < 3 ? *(const LAS f32x4*)(xf + (blk + 1) * 128 + cl0 + 4 * n) : (f32x4){0.f, 0.f, 0.f, 0.f};
                f32x4 lc_cur; SHF4(lc_cur, acc[ai][0][0][n], src_dn);
#pragma unroll
                for (int m = 0; m < 4; ++m) {
                    f32x4 rc_cur, lc_next; SHF4(rc_cur, acc[ai][0][m][n], src_up);
                    if (m < 3) SHF4(lc_next, acc[ai][0][m + 1][n], src_dn); else lc_next = bot;
                    f32x4 pre, g;
#pragma unroll
                    for (int e = 0; e < 4; ++e) { const float up = fr == 0 ? rc_prev[e] : rc_cur[e], dn = fr == 15 ? lc_next[e] : lc_cur[e];
                        const float p = w0[e] * up + w1[e] * acc[ai][0][m][n][e] + w2[e] * dn + bb[e];
                        pre[e] = p; g[e] = gelu_tanh_f(p) * acc[ai][1][m][n][e]; }
                    const int row = u.pm * BM + ai * HALF + wr * 64 + m * 16 + fr;
                    u32x2 wv; wv.x = cvt_pk_bf16(g[0], g[1]); wv.y = cvt_pk_bf16(g[2], g[3]);
                    *(u32x2*)(G + (size_t)row * DFF + f0 + 4 * n) = wv;
                    if (blk == 0 && m == 0 && fr == 0) { float* sp = side + (size_t)u.pm * DFF + f0 + 4 * n; *(f32x4*)sp = pre; *(f32x4*)(sp + 2 * SIDE_N) = acc[ai][0][m][n]; *(f32x4*)(sp + 4 * SIDE_N) = acc[ai][1][m][n]; }
                    if (blk == 3 && m == 3 && fr == 15) { float* sp = side + (size_t)u.pm * DFF + f0 + 4 * n; *(f32x4*)(sp + SIDE_N) = pre; *(f32x4*)(sp + 3 * SIDE_N) = acc[ai][0][m][n]; *(f32x4*)(sp + 5 * SIDE_N) = acc[ai][1][m][n]; }
                    rc_prev = rc_cur; lc_cur = lc_next;
                } } }
#undef SHF4
    }
};

template <class Epi, class Sched, bool ALIGN_EPI = true, bool SP2 = true>
__device__ __forceinline__ void gemm_phase(LAS unsigned char* lds, const Gemm g, const Sched& S, const Epi& E, int wid) {
    const int lane = fresh_lane(), tid = wid * 64 + lane, wr = wid >> 2, wc = wid & 3, fr = lane & 15, fq = lane >> 4;
    const int K = g.K, nt = K / BK;
    unsigned voffA[2], voffB[2];
#pragma unroll
    for (int i = 0; i < 2; ++i) { int R, C; stage_rc(tid * 16 + i * 8192, R, C); const int Rb = Epi::PERM ? ((R & ~31) + perm32(R & 31)) : R;
        voffA[i] = (unsigned)(R * g.lda + C) * 2u; voffB[i] = (unsigned)(Rb * g.ldb + C) * 2u; }
    const size_t kstep = (size_t)(BK * 2);
    const size_t hstepA = (size_t)HALF * g.lda * 2, hstepB = (size_t)HALF * g.ldb * 2;
    const size_t tstepA = 2 * hstepA, tstepB = 2 * hstepB;
    const unsigned ldsw = (unsigned)wid * 1024u;
    const int aoff = lds_byte(wr * 64 + fr, fq * 8), boff = lds_byte(wc * 32 + fr, fq * 8);
#define PG8_SA(b, h) (((b) * 2 + (h)) * HTB)
#define PG8_SB(b, h) ((4 + (b) * 2 + (h)) * HTB)
#define PG8_STAGE(bufoff, gbase, voff) do { _Pragma("unroll") for (int _i = 0; _i < 2; ++_i) \
        __builtin_amdgcn_global_load_lds((const unsigned*)((const char*)(gbase) + (voff)[_i]), (LAS unsigned*)(lds + (bufoff) + ldsw + _i * 8192), 16, 0, 0); } while (0)
#define PG8_LDA(dst, b, h) do { _Pragma("unroll") for (int m = 0; m < 4; ++m) _Pragma("unroll") for (int k = 0; k < 2; ++k) dst[m][k] = *(const LAS bf16x8*)(lds + PG8_SA(b, h) + aoff + m * 2048 + k * 1024); } while (0)
#define PG8_LDB(dst, b, h) do { _Pragma("unroll") for (int n = 0; n < 2; ++n) _Pragma("unroll") for (int k = 0; k < 2; ++k) dst[n][k] = *(const LAS bf16x8*)(lds + PG8_SB(b, h) + boff + n * 2048 + k * 1024); } while (0)
#define PG8_MMA(ai, bj, At, Bt) do { __builtin_amdgcn_s_setprio(1); _Pragma("unroll") for (int m = 0; m < 4; ++m) _Pragma("unroll") for (int n = 0; n < 2; ++n) _Pragma("unroll") for (int k = 0; k < 2; ++k) \
        acc[ai][bj][m][n] = __builtin_amdgcn_mfma_f32_16x16x32_bf16(Bt[n][k], At[m][k], acc[ai][bj][m][n], 0, 0, 0); __builtin_amdgcn_s_setprio(0); } while (0)
#define PG8_WAIT_V(n) asm volatile("s_waitcnt vmcnt(" #n ")" ::: "memory")
#define PG8_WAIT_L(n) asm volatile("s_waitcnt lgkmcnt(" #n ")" ::: "memory")
#define PG8_BAR __builtin_amdgcn_s_barrier()
#define PG8_SCHED __builtin_amdgcn_sched_barrier(0)
    Unit cur, nxt; int ui = 0;
    if (!S.next(0, cur)) return;
    f32x4 acc[2][2][4][2];
#pragma unroll
    for (int a = 0; a < 2; ++a)
#pragma unroll
        for (int b = 0; b < 2; ++b)
#pragma unroll
            for (int m = 0; m < 4; ++m)
#pragma unroll
                for (int n = 0; n < 2; ++n) acc[a][b][m][n] = (f32x4){0.f, 0.f, 0.f, 0.f};
    bf16x8 At[4][2], B0[2][2], B1[2][2];
    const char* cA = (const char*)(cur.sub ? g.A2 : g.A) + (size_t)cur.pm * tstepA; const char* cB = (const char*)(cur.sub ? g.Bt2 : g.Bt) + (size_t)cur.pn * tstepB;
    S.a_ready(cur);
    if constexpr (SP2) {
        PG8_STAGE(PG8_SB(0, 0), cB, voffB); PG8_STAGE(PG8_SB(0, 1), cB + hstepB, voffB); PG8_STAGE(PG8_SA(0, 0), cA, voffA); PG8_STAGE(PG8_SA(0, 1), cA + hstepA, voffA);
        if (wr == 1) PG8_BAR;
        PG8_WAIT_V(2); PG8_BAR;
        PG8_STAGE(PG8_SB(1, 0), cB + kstep, voffB); PG8_STAGE(PG8_SA(1, 0), cA + kstep, voffA); PG8_STAGE(PG8_SB(1, 1), cB + hstepB + kstep, voffB);
        PG8_WAIT_V(6); PG8_BAR;
    } else {
        PG8_STAGE(PG8_SB(0, 0), cB, voffB); PG8_STAGE(PG8_SA(0, 0), cA, voffA); PG8_STAGE(PG8_SB(0, 1), cB + hstepB, voffB); PG8_STAGE(PG8_SA(0, 1), cA + hstepA, voffA);
        if (wr == 1) PG8_BAR;
        PG8_WAIT_V(4); PG8_BAR;
        PG8_STAGE(PG8_SB(1, 0), cB + kstep, voffB); PG8_STAGE(PG8_SA(1, 0), cA + kstep, voffA); PG8_STAGE(PG8_SB(1, 1), cB + hstepB + kstep, voffB);
        PG8_WAIT_V(6); PG8_BAR;
    }
    for (;;) {
        const bool has_next = S.next(ui + 1, nxt);
        const char* nA = has_next ? (const char*)(nxt.sub ? g.A2 : g.A) + (size_t)nxt.pm * tstepA : cA; const char* nB = has_next ? (const char*)(nxt.sub ? g.Bt2 : g.Bt) + (size_t)nxt.pn * tstepB : cB;
        for (int t = 0; t < nt; t += 2) {
            const bool last = (t == nt - 2);
            const char* a1 = cA + (size_t)(t + 1) * kstep;
            const char* a2 = last ? nA : cA + (size_t)(t + 2) * kstep; const char* b2 = last ? nB : cB + (size_t)(t + 2) * kstep;
            const char* a3 = a2 + kstep; const char* b3 = b2 + kstep;
            if (last && has_next) S.a_ready(nxt);
            if constexpr (SP2) {
            PG8_LDB(B0, 0, 0); PG8_LDB(B1, 0, 1); PG8_SCHED; PG8_LDA(At, 0, 0); PG8_STAGE(PG8_SA(1, 1), a1 + hstepA, voffA);
            PG8_WAIT_V(8); PG8_WAIT_L(0); PG8_BAR; PG8_MMA(0, 0, At, B0); PG8_MMA(0, 1, At, B1); PG8_BAR; PG8_SCHED;
            PG8_LDA(At, 0, 1); PG8_STAGE(PG8_SB(0, 0), b2, voffB); PG8_STAGE(PG8_SB(0, 1), b2 + hstepB, voffB); PG8_STAGE(PG8_SA(0, 0), a2, voffA);
            PG8_WAIT_V(8); PG8_WAIT_L(0); PG8_BAR; PG8_MMA(1, 0, At, B0); PG8_MMA(1, 1, At, B1); PG8_BAR; PG8_SCHED;
            PG8_LDB(B0, 1, 0); PG8_LDB(B1, 1, 1); PG8_SCHED; PG8_LDA(At, 1, 0); PG8_STAGE(PG8_SA(0, 1), a2 + hstepA, voffA);
            PG8_WAIT_V(8); PG8_WAIT_L(0); PG8_BAR; PG8_MMA(0, 0, At, B0); PG8_MMA(0, 1, At, B1); PG8_BAR; PG8_SCHED;
            PG8_LDA(At, 1, 1); PG8_STAGE(PG8_SB(1, 0), b3, voffB); PG8_STAGE(PG8_SB(1, 1), b3 + hstepB, voffB); PG8_STAGE(PG8_SA(1, 0), a3, voffA);
            PG8_WAIT_V(8); PG8_WAIT_L(0); PG8_BAR; PG8_MMA(1, 0, At, B0); PG8_MMA(1, 1, At, B1); PG8_BAR; PG8_SCHED;
            } else {
            PG8_LDB(B0, 0, 0); PG8_SCHED; PG8_LDA(At, 0, 0); PG8_STAGE(PG8_SA(1, 1), a1 + hstepA, voffA);
            PG8_WAIT_L(8); PG8_BAR; PG8_WAIT_L(0); PG8_MMA(0, 0, At, B0); PG8_BAR; PG8_SCHED;
            PG8_LDB(B1, 0, 1); PG8_STAGE(PG8_SB(0, 0), b2, voffB);
            PG8_BAR; PG8_WAIT_L(0); PG8_MMA(0, 1, At, B1); PG8_BAR;
            PG8_LDA(At, 0, 1); PG8_STAGE(PG8_SA(0, 0), a2, voffA);
            PG8_BAR; PG8_WAIT_L(0); PG8_MMA(1, 0, At, B0); PG8_BAR; PG8_SCHED;
            PG8_STAGE(PG8_SB(0, 1), b2 + hstepB, voffB);
            PG8_WAIT_V(6); PG8_BAR; PG8_MMA(1, 1, At, B1); PG8_BAR;
            PG8_LDB(B0, 1, 0); PG8_SCHED; PG8_LDA(At, 1, 0); PG8_STAGE(PG8_SA(0, 1), a2 + hstepA, voffA);
            PG8_WAIT_L(8); PG8_BAR; PG8_WAIT_L(0); PG8_MMA(0, 0, At, B0); PG8_BAR; PG8_SCHED;
            PG8_LDB(B1, 1, 1); PG8_STAGE(PG8_SB(1, 0), b3, voffB);
            PG8_BAR; PG8_WAIT_L(0); PG8_MMA(0, 1, At, B1); PG8_BAR;
            PG8_LDA(At, 1, 1); PG8_STAGE(PG8_SA(1, 0), a3, voffA);
            PG8_BAR; PG8_WAIT_L(0); PG8_MMA(1, 0, At, B0); PG8_BAR; PG8_SCHED;
            PG8_STAGE(PG8_SB(1, 1), b3 + hstepB, voffB);
            PG8_WAIT_V(6); PG8_BAR; PG8_MMA(1, 1, At, B1); PG8_BAR;
            }
        }
        if constexpr (ALIGN_EPI) { if (wr == 0) PG8_BAR; }
        if constexpr (!Epi::AFTER_DRAIN) { E(acc, cur, wr, wc, fr, fq); S.done(cur); }
        if (!has_next) break;
        if (nxt.sub == 0) {
#pragma unroll
        for (int a = 0; a < 2; ++a)
#pragma unroll
            for (int b = 0; b < 2; ++b)
#pragma unroll
                for (int m = 0; m < 4; ++m)
#pragma unroll
                    for (int n = 0; n < 2; ++n) acc[a][b][m][n] = (f32x4){0.f, 0.f, 0.f, 0.f};
        }
        cur = nxt; cA = nA; cB = nB; ++ui;
        if constexpr (ALIGN_EPI) { if (wr == 1) PG8_BAR; }
    }
    PG8_WAIT_V(0);
    if constexpr (!ALIGN_EPI) { if (wr == 0) PG8_BAR; }
    PG8_BAR;
#undef PG8_SA
#undef PG8_SB
#undef PG8_STAGE
#undef PG8_LDA
#undef PG8_LDB
#undef PG8_MMA
#undef PG8_WAIT_V
#undef PG8_WAIT_L
#undef PG8_BAR
#undef PG8_SCHED
}
}

namespace mla {
constexpr int NW = 8, QBLK = 32, KVBLK = 64;
constexpr float SCALE = 0.07216878364870322f;
constexpr float THR = 8.f;
constexpr int SDEPTH = 1;
constexpr int LDQ = 3072, LDKN = 2048, LDKP = 64, LDV = 2048, LDO = 2048;
constexpr int SHM_V = KVBLK * 128 * 2, SHM_K = KVBLK * 400, SHM_QPE = 2 * SHM_V + 2 * SHM_K + NW * 64 * 4, SHM_ATTN = SHM_QPE + NW * 8704;
#define KSWZ(row, colB) ((row) * 400 + (colB))
#define SBAR() __builtin_amdgcn_sched_barrier(0)
__device__ __forceinline__ int crow(int r, int hi) { return (r & 3) + 8 * (r >> 2) + 4 * hi; }

constexpr int NQR = 12, NQL = 12 - NQR;
__device__ __forceinline__ int qlds_off(int r32, int c) { return r32 * 272 + c * 16; }
__device__ __forceinline__ int v_st(int k, int c) { const int kk = (k & ~0xC) | ((k & 4) << 1) | ((k & 8) >> 1); return ((kk >> 3) * 4 + (c >> 5)) * 512 + ((kk & 7) * 32 + (c & 31)) * 2; }
__device__ __forceinline__ int v_rd_base(int lane) { return ((lane & 3) << 3) | (((lane >> 2) & 3) << 6) | (((lane >> 4) & 1) << 5) | (((lane >> 5) & 1) << 8); }
constexpr int v_rd_off(int d0, int ks, int half) { return d0 * 512 + ks * 4096 + half * 2048; }
template <int OFF> __device__ __forceinline__ s16x4 tr_read(int vb) {
  s16x4 r; asm volatile("ds_read_b64_tr_b16 %0, %1 offset:%2" : "=&v"(r) : "v"(vb), "i"(OFF) : "memory"); return r;
}
#ifndef MLA_KLA
#define MLA_KLA 3
#endif
#ifndef MLA_PVA
#define MLA_PVA 4
#endif
constexpr int PVA = MLA_PVA, KLA = MLA_KLA;
template <int I> __device__ __forceinline__ void tr_pair(s16x4& lo, s16x4& hi_, int vb) { lo = tr_read<v_rd_off(I >> 2, I & 3, 0)>(vb); hi_ = tr_read<v_rd_off(I >> 2, I & 3, 1)>(vb); }
template <int I> __device__ __forceinline__ void tr_pairs(s16x4 (&LO)[16], s16x4 (&HI)[16], int vb) { if constexpr (I < PVA) { tr_pair<I>(LO[I], HI[I], vb); tr_pairs<I + 1>(LO, HI, vb); } }
template <int I> __device__ __forceinline__ void pv_step(f32x16* o, s16x4 (&LO)[16], s16x4 (&HI)[16], int vb, bf16x8 pa0, bf16x8 pa1, bf16x8 pa2, bf16x8 pa3) {
  if constexpr (I + PVA < 16) tr_pair<I + PVA>(LO[I + PVA], HI[I + PVA], vb);
  if constexpr (I + PVA < 16) asm volatile("s_waitcnt lgkmcnt(%0)" :: "n"(2 * PVA) : "memory");
  else asm volatile("s_waitcnt lgkmcnt(%0)" :: "n"(2 * (15 - I)) : "memory");
  SBAR();
  const bf16x8 pa = (I & 3) == 0 ? pa0 : ((I & 3) == 1 ? pa1 : ((I & 3) == 2 ? pa2 : pa3));
  const bf16x8 bv = (bf16x8){LO[I][0], LO[I][1], LO[I][2], LO[I][3], HI[I][0], HI[I][1], HI[I][2], HI[I][3]};
  o[I >> 2] = __builtin_amdgcn_mfma_f32_32x32x16_bf16(pa, bv, o[I >> 2], 0, 0, 0); SBAR();
}
template <int I> __device__ __forceinline__ void pv_steps(f32x16* o, s16x4 (&LO)[16], s16x4 (&HI)[16], int vb, bf16x8 pa0, bf16x8 pa1, bf16x8 pa2, bf16x8 pa3) {
  if constexpr (I < 16) { pv_step<I>(o, LO, HI, vb, pa0, pa1, pa2, pa3); pv_steps<I + 1>(o, LO, HI, vb, pa0, pa1, pa2, pa3); }
}
template <bool DO_PV>
__device__ __forceinline__ void m_phase(f32x16& p0, f32x16& p1, f32x16* o, const char* Ks, const bf16x8* qr, const char* qls, int vb, int r32, int hi,
                                        bf16x8 pa0, bf16x8 pa1, bf16x8 pa2, bf16x8 pa3) {
  bf16x8 B0[12], B1[12], QL[12]; s16x4 LO[16], HI[16];
  const char* k0p = Ks + KSWZ(r32, hi * 16); const char* k1p = Ks + KSWZ(32 + r32, hi * 16); const char* qp = qls + qlds_off(r32, hi);
#define KLD(d) do { B0[d] = *reinterpret_cast<const bf16x8*>(k0p + (d) * 32); B1[d] = *reinterpret_cast<const bf16x8*>(k1p + (d) * 32); \
    if ((d) >= NQR) QL[d] = *reinterpret_cast<const bf16x8*>(qp + ((d) - NQR) * 32); } while (0)
  SBAR();
#pragma unroll
  for (int d = 0; d < KLA; ++d) KLD(d);
  SBAR();
  p0 = f32x16{}; p1 = f32x16{};
#pragma unroll
  for (int d = 0; d < 12; ++d) {
    if (d + KLA < 12) { KLD(d + KLA); }
    SBAR();
    const bf16x8 q = d < NQR ? qr[d < NQR ? d : 0] : QL[d];
    p0 = __builtin_amdgcn_mfma_f32_32x32x16_bf16(B0[d], q, p0, 0, 0, 0);
    p1 = __builtin_amdgcn_mfma_f32_32x32x16_bf16(B1[d], q, p1, 0, 0, 0); SBAR();
  }
#undef KLD
  if constexpr (DO_PV) {
    tr_pairs<0>(LO, HI, vb); SBAR();
    pv_steps<0>(o, LO, HI, vb, pa0, pa1, pa2, pa3);
  }
}
__device__ __forceinline__ void pv_pipe(f32x16* o, int vb, bf16x8 pa0, bf16x8 pa1, bf16x8 pa2, bf16x8 pa3) {
  s16x4 LO[16], HI[16];
  SBAR(); tr_pairs<0>(LO, HI, vb); SBAR();
  pv_steps<0>(o, LO, HI, vb, pa0, pa1, pa2, pa3);
}
__device__ __forceinline__ void softmax_tile(f32x16& p0, f32x16& p1, float& m_reg, float& l_reg, float& alpha, bf16x8& pa0, bf16x8& pa1, bf16x8& pa2, bf16x8& pa3) {
  constexpr float C = SCALE * 1.4426950408889634f;
  float pmax = p0[0];
#pragma unroll
  for (int r = 1; r < 16; ++r) pmax = fmaxf(pmax, p0[r]);
#pragma unroll
  for (int r = 0; r < 16; ++r) pmax = fmaxf(pmax, p1[r]);
  { auto rr = __builtin_amdgcn_permlane32_swap(__float_as_uint(pmax), __float_as_uint(pmax), false, false);
    pmax = fmaxf(__uint_as_float(rr[0]), __uint_as_float(rr[1])); }
  float mn;
  if (__builtin_expect(__all(pmax - m_reg <= THR / SCALE), 1)) { mn = m_reg; alpha = 1.f; }
  else { mn = fmaxf(m_reg, pmax); alpha = __builtin_amdgcn_exp2f((m_reg - mn) * C); m_reg = mn; }
  const float mnC = -mn * C;
#pragma unroll
  for (int r = 0; r < 16; ++r) p0[r] = __builtin_amdgcn_exp2f(fmaf(p0[r], C, mnC));
#pragma unroll
  for (int r = 0; r < 16; ++r) p1[r] = __builtin_amdgcn_exp2f(fmaf(p1[r], C, mnC));
  float ps = 0;
#pragma unroll
  for (int r = 0; r < 16; ++r) ps += p0[r];
#pragma unroll
  for (int r = 0; r < 16; ++r) ps += p1[r];
  { auto rr = __builtin_amdgcn_permlane32_swap(__float_as_uint(ps), __float_as_uint(ps), false, false);
    ps = __uint_as_float(rr[0]) + __uint_as_float(rr[1]); }
  l_reg = l_reg * alpha + ps;
#define PK4(P, BASE, OUT) do { unsigned a0 = cvt_pk_bf16(P[BASE + 0], P[BASE + 1]), a1 = cvt_pk_bf16(P[BASE + 2], P[BASE + 3]);   \
    unsigned b0 = cvt_pk_bf16(P[BASE + 4], P[BASE + 5]), b1 = cvt_pk_bf16(P[BASE + 6], P[BASE + 7]);                              \
    auto r0 = __builtin_amdgcn_permlane32_swap(a0, b0, false, false); auto r1 = __builtin_amdgcn_permlane32_swap(a1, b1, false, false); \
    u32x4 w = {r0[0], r1[0], r0[1], r1[1]}; OUT = *reinterpret_cast<bf16x8*>(&w); } while (0)
  PK4(p0, 0, pa0); PK4(p0, 8, pa1); PK4(p1, 0, pa2); PK4(p1, 8, pa3);
#undef PK4
}
#define MLA_BAR() do { SBAR(); asm volatile("s_waitcnt lgkmcnt(0)" ::: "memory"); __builtin_amdgcn_s_barrier(); asm volatile("" ::: "memory"); SBAR(); } while (0)
__device__ __forceinline__ void attn_body2(const bf16_t* __restrict__ Qb, const bf16_t* __restrict__ Kn, const bf16_t* __restrict__ Kp, const bf16_t* __restrict__ Vh,
                                           bf16_t* __restrict__ Ob, int seq, int pos0, const float* __restrict__ tcos, const float* __restrict__ tsin, char* lds, int wid) {
  const int lane = fresh_lane(), tid = wid * 64 + lane, r32 = lane & 31, hi = lane >> 5, half = wid >> 2;
  char* V_lds = lds; char* K_lds = lds + 2 * SHM_V;
  float* ws = (float*)(lds + 2 * SHM_V + 2 * SHM_K) + wid * 64; float* li_l = ws; float* al_l = ws + 32;
  float m_reg = -1e30f, l_reg = 0; f32x16 o[4] = {}; bf16x8 qr[NQR]; char* qpe = lds + SHM_QPE + wid * 8704;
  const bf16_t* Qw = Qb + (long)(wid * QBLK + r32) * LDQ + hi * 8;
#pragma unroll
  for (int d0 = 0; d0 < (NQR < 8 ? NQR : 8); ++d0) qr[d0] = *reinterpret_cast<const bf16x8*>(Qw + d0 * 16);
#pragma unroll
  for (int d0 = NQR; d0 < 8; ++d0) *reinterpret_cast<bf16x8*>(qpe + qlds_off(r32, (d0 - NQR) * 2 + hi)) = *reinterpret_cast<const bf16x8*>(Qw + d0 * 16);
  {
    const int pos = pos0 + wid * QBLK + r32;
#pragma unroll
    for (int part = 0; part < 2; ++part) {
      const float* cp = tcos + (size_t)pos * 32 + part * 16 + hi * 8; const float* sp = tsin + (size_t)pos * 32 + part * 16 + hi * 8;
      const f32x4 c0 = *(const f32x4*)cp, c1 = *(const f32x4*)(cp + 4), s0 = *(const f32x4*)sp, s1 = *(const f32x4*)(sp + 4);
      bf16x8 xa = *reinterpret_cast<const bf16x8*>(Qw + (8 + part) * 16), xb = *reinterpret_cast<const bf16x8*>(Qw + (10 + part) * 16); u32x4 wa, wb;
      float ya[8], yb[8];
#pragma unroll
      for (int j = 0; j < 8; ++j) { const float x1 = bf2f((unsigned short)xa[j]), x2 = bf2f((unsigned short)xb[j]); const float c = j < 4 ? c0[j] : c1[j - 4], s = j < 4 ? s0[j] : s1[j - 4];
        ya[j] = x1 * c - x2 * s; yb[j] = x1 * s + x2 * c; }
      wa.x = cvt_pk_bf16(ya[0], ya[1]); wa.y = cvt_pk_bf16(ya[2], ya[3]); wa.z = cvt_pk_bf16(ya[4], ya[5]); wa.w = cvt_pk_bf16(ya[6], ya[7]);
      wb.x = cvt_pk_bf16(yb[0], yb[1]); wb.y = cvt_pk_bf16(yb[2], yb[3]); wb.z = cvt_pk_bf16(yb[4], yb[5]); wb.w = cvt_pk_bf16(yb[6], yb[7]);
      if constexpr (8 + 1 < NQR) qr[8 + part] = *reinterpret_cast<bf16x8*>(&wa); else *reinterpret_cast<u32x4*>(qpe + qlds_off(r32, (8 + part - NQR) * 2 + hi)) = wa;
      if constexpr (10 + 1 < NQR) qr[10 + part] = *reinterpret_cast<bf16x8*>(&wb); else *reinterpret_cast<u32x4*>(qpe + qlds_off(r32, (10 + part - NQR) * 2 + hi)) = wb;
    }
  }
  const int sr = tid >> 4, sc = (tid & 15) * 8, vst0 = v_st(sr, sc), vst1 = v_st(32 + sr, sc);
  const int pr = tid >> 3, pc = (tid & 7) * 8;
  const int vb0 = (int)(uintptr_t)V_lds + v_rd_base(lane);
  bf16x8 st_vs0, st_vs1, st_ks0, st_ks1, st_kp;
#define LOADK(kt) do { st_ks0 = *(const bf16x8*)(&Kn[(long)((kt) * KVBLK + sr) * LDKN + sc]); st_ks1 = *(const bf16x8*)(&Kn[(long)((kt) * KVBLK + 32 + sr) * LDKN + sc]); \
    st_kp = *(const bf16x8*)(&Kp[(long)((kt) * KVBLK + pr) * LDKP + pc]); } while (0)
#define LOADV(vt) do { st_vs0 = *(const bf16x8*)(&Vh[(long)((vt) * KVBLK + sr) * LDV + sc]); st_vs1 = *(const bf16x8*)(&Vh[(long)((vt) * KVBLK + 32 + sr) * LDV + sc]); } while (0)
#define WRITEK(b) do { char* kb_ = K_lds + (b) * SHM_K; *(bf16x8*)(kb_ + KSWZ(sr, sc * 2)) = st_ks0; *(bf16x8*)(kb_ + KSWZ(32 + sr, sc * 2)) = st_ks1; *(bf16x8*)(kb_ + KSWZ(pr, 256 + pc * 2)) = st_kp; } while (0)
#define WRITEV(b) do { char* vb_ = V_lds + (b) * SHM_V; *(bf16x8*)(vb_ + vst0) = st_vs0; *(bf16x8*)(vb_ + vst1) = st_vs1; } while (0)
#define RESC(a) do { if (__any((a) < 1.f)) { if (hi == 0) al_l[r32] = (a); asm volatile("s_waitcnt lgkmcnt(0)" ::: "memory"); \
    _Pragma("unroll") for (int d = 0; d < 4; ++d) _Pragma("unroll") for (int r = 0; r < 16; ++r) o[d][r] *= al_l[crow(r, hi)]; } } while (0)
  const int NT = seq / KVBLK;
  LOADK(0); LOADV(0); WRITEK(0); WRITEV(0); LOADK(1); WRITEK(1);
  if (2 < NT) LOADK(2);
  LOADV(1);
  MLA_BAR();
  if (half == 1) MLA_BAR();
  f32x16 p0, p1; float alpha; bf16x8 pa0, pa1, pa2, pa3;
#define VPHASE(t) do { softmax_tile(p0, p1, m_reg, l_reg, alpha, pa0, pa1, pa2, pa3); RESC(alpha); \
    const int n_ = (t) + half - 1; \
    if (n_ >= 0) { const int kb_i = n_ & 1, vb_i = (n_ + 1) & 1; if (n_ + 2 < NT) WRITEK(kb_i); if (n_ + 1 < NT) WRITEV(vb_i); \
      if (n_ + 3 < NT) LOADK(n_ + 3); if (n_ + 2 < NT) LOADV(n_ + 2); } } while (0)
  pa0 = pa1 = pa2 = pa3 = bf16x8{};
  m_phase<false>(p0, p1, o, K_lds, qr, qpe, vb0, r32, hi, pa0, pa1, pa2, pa3); MLA_BAR();
  VPHASE(0); MLA_BAR();
  for (int t = 1; t + 1 < NT; t += 2) {
    m_phase<true>(p0, p1, o, K_lds + SHM_K, qr, qpe, vb0, r32, hi, pa0, pa1, pa2, pa3); MLA_BAR();
    VPHASE(t); MLA_BAR();
    m_phase<true>(p0, p1, o, K_lds, qr, qpe, vb0 + (int)SHM_V, r32, hi, pa0, pa1, pa2, pa3); MLA_BAR();
    VPHASE(t + 1); MLA_BAR();
  }
  { const int t = NT - 1;
    m_phase<true>(p0, p1, o, K_lds + SHM_K, qr, qpe, vb0, r32, hi, pa0, pa1, pa2, pa3); MLA_BAR();
    VPHASE(t); MLA_BAR(); }
  pv_pipe(o, vb0 + (int)SHM_V, pa0, pa1, pa2, pa3); MLA_BAR();
  if (half == 0) MLA_BAR();
  if (hi == 0) li_l[r32] = l_reg; asm volatile("s_waitcnt lgkmcnt(0)" ::: "memory");
  float rli[16];
#pragma unroll
  for (int r = 0; r < 16; ++r) rli[r] = __builtin_amdgcn_rcpf(li_l[crow(r, hi)]);
  bf16_t* Ow = Ob + (long)(wid * QBLK) * LDO;
#pragma unroll
  for (int r = 0; r < 16; ++r) { int orow = crow(r, hi);
#pragma unroll
    for (int d0 = 0; d0 < 4; ++d0) Ow[(long)orow * LDO + d0 * 32 + r32] = (bf16_t)(cvt_pk_bf16(o[d0][r] * rli[r], 0.f) & 0xffffu); }
  MLA_BAR();
#undef LOADK
#undef LOADV
#undef WRITEK
#undef WRITEV
#undef RESC
#undef VPHASE
}
}

#define XB_TMO      128
#define XB_XCNT(j)  (256  + 64 * (j))
#define XB_XSUB(j)  (1280 + 64 * (j))
#define XB_XGEN(j)  (2304 + 64 * (j))
#define XB_TOP      3328
#define XB_TOPGEN   3392
#define XCD_BAR_WORDS 3456
#define XB_SPIN_CAP (1u << 18)
__device__ __forceinline__ unsigned xb_ld(unsigned* p)              { return __hip_atomic_load(p, __ATOMIC_RELAXED, __HIP_MEMORY_SCOPE_AGENT); }
__device__ __forceinline__ unsigned xb_add(unsigned* p, unsigned v) { return __hip_atomic_fetch_add(p, v, __ATOMIC_RELAXED, __HIP_MEMORY_SCOPE_AGENT); }
__device__ __forceinline__ unsigned xb_xcc_id() { return (unsigned)__builtin_amdgcn_s_getreg((3 << 11) | 20) & 0xFu; }
#define XB_SPIN(cond, bar) do { unsigned _sp = 0; while (cond) { __builtin_amdgcn_s_sleep(1); \
    if ((++_sp & 255u) == 0u) { if (xb_ld(&(bar)[XB_TMO])) break; if (_sp > XB_SPIN_CAP) { atomicAdd(&(bar)[XB_TMO], 1u); break; } } } } while (0)
struct XcdBarrier { unsigned* bar; unsigned x; volatile LAS unsigned* st; int wave; };
__device__ __forceinline__ XcdBarrier xcd_barrier_post(unsigned* bar, volatile LAS unsigned* st, int wave) {
    XcdBarrier b; b.bar = bar; b.x = xb_xcc_id(); b.st = st; b.wave = wave;
    if (wave == 0 && fresh_lane() == 0) (void)xb_add(&bar[XB_XCNT(b.x)], 1u);
    return b;
}
__device__ __forceinline__ void xcd_barrier_complete(unsigned* bar, unsigned x, unsigned& nloc, unsigned& nx) {
    const unsigned G = gridDim.x * gridDim.y * gridDim.z;
    unsigned sum, cnt, mine, sp = 0u;
    for (;;) {
        sum = 0u; cnt = 0u; mine = 0u;
#pragma unroll
        for (unsigned j = 0; j < 16; ++j) { const unsigned c = xb_ld(&bar[XB_XCNT(j)]); sum += c; cnt += (c > 0u) ? 1u : 0u; mine = (j == x) ? c : mine; }
        if (sum == G) break;
        __builtin_amdgcn_s_sleep(1);
        if ((++sp & 255u) == 0u) { if (xb_ld(&bar[XB_TMO])) break; if (sp > XB_SPIN_CAP) { atomicAdd(&bar[XB_TMO], 1u); break; } }
    }
    nloc = mine > 0u ? mine : 1u; nx = cnt > 0u ? cnt : 1u;
}
__device__ __forceinline__ void xcd_barrier(const XcdBarrier& b) {
    asm volatile("s_waitcnt vmcnt(0)" ::: "memory");
    __syncthreads();
    if (b.wave == 0 && fresh_lane() == 0) {
        unsigned* bar = b.bar;
        __builtin_amdgcn_s_waitcnt(0);
        unsigned nloc = b.st[0], nx = b.st[1];
        if (nloc == 0u) { xcd_barrier_complete(bar, b.x, nloc, nx); b.st[0] = nloc; b.st[1] = nx; }
        const unsigned old = xb_add(&bar[XB_XSUB(b.x)], 1u);
        const unsigned gen = old / nloc;
        if (old + 1u == (gen + 1u) * nloc) {
            __builtin_amdgcn_fence(__ATOMIC_RELEASE, "agent");
            asm volatile("s_waitcnt vmcnt(0)" ::: "memory");
            const unsigned og = xb_add(&bar[XB_TOP], 1u);
            const unsigned tg = og / nx;
            if (og + 1u == (tg + 1u) * nx) xb_add(&bar[XB_TOPGEN], 1u);
            else XB_SPIN(xb_ld(&bar[XB_TOPGEN]) == tg, bar);
            __builtin_amdgcn_fence(__ATOMIC_ACQUIRE, "agent");
            xb_add(&bar[XB_XGEN(b.x)], 1u);
            asm volatile("s_waitcnt vmcnt(0)" ::: "memory");
        } else {
            XB_SPIN(xb_ld(&bar[XB_XGEN(b.x)]) == gen, bar);
            __builtin_amdgcn_fence(__ATOMIC_ACQUIRE, "agent");
            asm volatile("s_waitcnt vmcnt(0)" ::: "memory");
        }
    }
    __syncthreads();
}

struct Frame {
    LAS unsigned char* lds; char* ldsg;
    volatile LAS unsigned* MISC;
    unsigned* ctl;
    int tid, lane, wave, vcu, G;
    const float* in[23]; float* out; unsigned char* ws;
};
__device__ __forceinline__ float wave_sum(float v) {
#pragma unroll
    for (int o = 1; o < 64; o <<= 1) v += __shfl_xor(v, o);
    return v;
}
__device__ __forceinline__ const float* xrow(const Frame& F, int m) { return m < MP ? F.in[0] + (size_t)m * DM : F.in[1] + (size_t)(m - MP) * DM; }
__device__ __forceinline__ int seq_of(int m) { return m < MP ? (m >> 11) : 4; }
__device__ __forceinline__ int pos_of(int m) { return m < MP ? (m & (LP - 1)) : (m - MP); }

__device__ __forceinline__ void p0_mod(Frame& F) {
    LAS float* sc = (LAS float*)F.lds;
    LAS float* red = (LAS float*)(F.lds + 81920);
    const float* cpr = F.in[2]; const float* csm = F.in[3]; const float* wada = F.in[4]; const float* bada = F.in[5];
    float* mod = (float*)(F.ws + WS_MOD);
    for (int i = F.tid; i < 5 * DM; i += 512) { const float c = (i < 4 * DM) ? cpr[i] : csm[i - 4 * DM]; sc[i] = c * fast_sigmoid(c); }
    __syncthreads();
    const int cg = F.tid % 24, kr = F.tid / 24;
    for (int chunk = F.vcu; chunk < 256; chunk += F.G) {
        float a0[4] = {0, 0, 0, 0}, a1[4] = {0, 0, 0, 0}, a2[4] = {0, 0, 0, 0}, a3[4] = {0, 0, 0, 0}, a4[4] = {0, 0, 0, 0};
        if (kr < 21) {
            const float* wp = wada + chunk * 96 + cg * 4;
#pragma unroll 4
            for (int k = kr; k < DM; k += 21) {
                const f32x4 w = *(const f32x4*)(wp + (size_t)k * NMOD);
                const float s0 = sc[k], s1 = sc[DM + k], s2 = sc[2 * DM + k], s3 = sc[3 * DM + k], s4 = sc[4 * DM + k];
#pragma unroll
                for (int e = 0; e < 4; ++e) { a0[e] += s0 * w[e]; a1[e] += s1 * w[e]; a2[e] += s2 * w[e]; a3[e] += s3 * w[e]; a4[e] += s4 * w[e]; }
            }
#pragma unroll
            for (int e = 0; e < 4; ++e) { red[(kr * 5 + 0) * 96 + cg * 4 + e] = a0[e]; red[(kr * 5 + 1) * 96 + cg * 4 + e] = a1[e]; red[(kr * 5 + 2) * 96 + cg * 4 + e] = a2[e];
                red[(kr * 5 + 3) * 96 + cg * 4 + e] = a3[e]; red[(kr * 5 + 4) * 96 + cg * 4 + e] = a4[e]; }
        }
        __syncthreads();
        if (F.tid < 480) { const int r = F.tid / 96, c = F.tid % 96; float s = 0.f;
            for (int q = 0; q < 21; ++q) s += red[(q * 5 + r) * 96 + c];
            mod[r * NMOD + chunk * 96 + c] = s + bada[chunk * 96 + c]; }
        __syncthreads();
    }
}
__device__ __forceinline__ void p0_transpose_item(const float* W, int ldw, int n0, int k0, bf16_t* WT, int drow0, int ldk, const float* kscale, LAS float* scr, int lane) {
#pragma unroll 8
    for (int i = 0; i < 32; ++i) { const int kk = 2 * i + (lane >> 5); float v = W[(size_t)(k0 + kk) * ldw + n0 + (lane & 31)]; if (kscale) v *= kscale[k0 + kk]; scr[kk * 33 + (lane & 31)] = v; }
    LDS_WAIT(); asm volatile("" ::: "memory");
    const int c = lane & 7;
#pragma unroll
    for (int j = 0; j < 4; ++j) { const int n = (lane >> 3) + 8 * j; const LAS float* s = scr + (8 * c) * 33 + n;
        u32x4 o; o.x = cvt_pk_bf16(s[0 * 33], s[1 * 33]); o.y = cvt_pk_bf16(s[2 * 33], s[3 * 33]); o.z = cvt_pk_bf16(s[4 * 33], s[5 * 33]); o.w = cvt_pk_bf16(s[6 * 33], s[7 * 33]);
        *(u32x4*)(WT + (size_t)(drow0 + n) * ldk + k0 + 8 * c) = o; }
    LDS_WAIT(); asm volatile("" ::: "memory");
}
__device__ __forceinline__ int zin_dst_row(int n0) {
    if (n0 < 4096) return n0;
    if (n0 < 6144) return 13824 + (n0 - 4096);
    if (n0 < 7040) return 4096 + (n0 - 6144);
    if (n0 < 7552) return 5120 + (n0 - 7040);
    if (n0 < 7616) return 4992 + (n0 - 7552);
    if (n0 < 11712) return 5632 + (n0 - 7616);
    return 9728 + (n0 - 11712);
}
__device__ __forceinline__ void p0_weights(Frame& F) {
    LAS float* scr = (LAS float*)(F.lds + F.wave * 16384);
    const int gw = F.vcu * NWAVES + F.wave, NGW = F.G * NWAVES;
    constexpr int I_IN = (DM / 64) * (INW / 32), I_UQ = (QLORA / 64) * (3072 / 32), I_UKV = (KVLORA / 64) * (4096 / 32), I_NA = (NAW / 64) * (DM / 32), I_MLA = I_NA,
                  I_OUT = (DM / 64) * (DM / 32), I_FFN = (DM / 64) * (2 * DFF / 32), I_DOWN = (DFF / 64) * (DM / 32);
    constexpr int NITEMS = I_IN + I_UQ + I_UKV + I_NA + I_MLA + I_OUT + I_FFN + I_DOWN;
    for (int it = gw; it < NITEMS; it += NGW) {
        int r = it;
        if (r < I_IN) { const int nblk = INW / 32, kb = r / nblk, nb = r % nblk; p0_transpose_item(F.in[8], INW, 32 * nb, 64 * kb, (bf16_t*)(F.ws + WS_BIN), zin_dst_row(32 * nb), DM, nullptr, scr, F.lane); continue; } r -= I_IN;
        if (r < I_UQ) { const int nblk = 3072 / 32, kb = r / nblk, nb = r % nblk; p0_transpose_item(F.in[11], 3072, 32 * nb, 64 * kb, (bf16_t*)(F.ws + WS_BUQ), 32 * nb, QLORA, F.in[10], scr, F.lane); continue; } r -= I_UQ;
        if (r < I_UKV) { const int nblk = 4096 / 32, kb = r / nblk, nb = r % nblk; p0_transpose_item(F.in[13], 4096, 32 * nb, 64 * kb, (bf16_t*)(F.ws + WS_BUKV), 32 * nb, KVLORA, F.in[12], scr, F.lane); continue; } r -= I_UKV;
        if (r < I_NA) { const int nblk = DM / 32, kb = r / nblk, nb = r % nblk; p0_transpose_item(F.in[14], DM, 32 * nb, 64 * kb, (bf16_t*)(F.ws + WS_BNA), 32 * nb, NAW, nullptr, scr, F.lane); continue; } r -= I_NA;
        if (r < I_MLA) { const int nblk = DM / 32, kb = r / nblk, nb = r % nblk; p0_transpose_item(F.in[15], DM, 32 * nb, 64 * kb, (bf16_t*)(F.ws + WS_BMLA), 32 * nb, NAW, nullptr, scr, F.lane); continue; } r -= I_MLA;
        if (r < I_OUT) { const int nblk = DM / 32, kb = r / nblk, nb = r % nblk; p0_transpose_item(F.in[16], DM, 32 * nb, 64 * kb, (bf16_t*)(F.ws + WS_BOUT), 32 * nb, DM, nullptr, scr, F.lane); continue; } r -= I_OUT;
        if (r < I_FFN) { const int nblk = 2 * DFF / 32, kb = r / nblk, nb = r % nblk; const int n0 = 32 * nb, fch = n0 < DFF ? n0 : n0 - DFF, drow = 256 * (fch >> 7) + (n0 < DFF ? 0 : 128) + (fch & 127);
            p0_transpose_item(F.in[19], 2 * DFF, n0, 64 * kb, (bf16_t*)(F.ws + WS_BFFN), drow, DM, nullptr, scr, F.lane); continue; } r -= I_FFN;
        { const int nblk = DM / 32, kb = r / nblk, nb = r % nblk; p0_transpose_item(F.in[22], DM, 32 * nb, 64 * kb, (bf16_t*)(F.ws + WS_BDOWN), 32 * nb, DFF, nullptr, scr, F.lane); }
    }
}
__device__ __forceinline__ void p0_tables(Frame& F) {
    float* tc = (float*)(F.ws + WS_TBLC); float* ts = (float*)(F.ws + WS_TBLS);
    const int gt = F.vcu * 512 + F.tid, NT = F.G * 512;
    for (int idx = gt; idx < LS * 32; idx += NT) {
        const int pos = idx >> 5, i = idx & 31;
        double inv = 1.0; const double rr = 0.74989420933245582730;
        for (int q = 0; q < i; ++q) inv *= rr;
        const double ang = (double)pos * inv;
        const double TWO_PI = 6.283185307179586476925, n = __builtin_rint(ang / TWO_PI);
        double r = ang - n * TWO_PI;
        const double x = r * 0.25, x2 = x * x;
        double s = x * (1.0 + x2 * (-1.0 / 6 + x2 * (1.0 / 120 + x2 * (-1.0 / 5040 + x2 * (1.0 / 362880 + x2 * (-1.0 / 39916800 + x2 * (1.0 / 6227020800.0)))))));
        double c = 1.0 + x2 * (-0.5 + x2 * (1.0 / 24 + x2 * (-1.0 / 720 + x2 * (1.0 / 40320 + x2 * (-1.0 / 3628800 + x2 * (1.0 / 479001600.0 + x2 * (-1.0 / 87178291200.0)))))));
        double s2 = 2.0 * s * c, c2 = 1.0 - 2.0 * s * s;
        double s4 = 2.0 * s2 * c2, c4 = 1.0 - 2.0 * s2 * s2;
        tc[idx] = (float)c4; ts[idx] = (float)s4;
    }
}
__device__ __forceinline__ void t1_norm(Frame& F) {
    const int gw = F.vcu * NWAVES + F.wave, NGW = F.G * NWAVES;
    const float* mod = (const float*)(F.ws + WS_MOD); const float* g = F.in[6]; bf16_t* H = (bf16_t*)(F.ws + WS_H);
    for (int mp = gw; mp < MTOK / 2; mp += NGW) {
        int lane = F.lane; asm volatile("" : "+v"(lane));
        const int m = 2 * mp;
        const f32x4* xr = (const f32x4*)xrow(F, m) + lane; const float* md = mod + (size_t)seq_of(m) * NMOD;
        f32x4 v[16], u[16]; float s = 0.f, t = 0.f;
#pragma unroll
        for (int j = 0; j < 16; ++j) { v[j] = xr[64 * j]; u[j] = xr[64 * j + DM / 4];
            s += (v[j].x * v[j].x + v[j].y * v[j].y) + (v[j].z * v[j].z + v[j].w * v[j].w); t += (u[j].x * u[j].x + u[j].y * u[j].y) + (u[j].z * u[j].z + u[j].w * u[j].w); }
        const float rs0 = 1.0f / sqrtf(wave_sum(s) * (1.f / DM) + EPS), rs1 = 1.0f / sqrtf(wave_sum(t) * (1.f / DM) + EPS);
        u32x2* o8 = (u32x2*)(H + (size_t)m * DM) + lane;
#pragma unroll
        for (int j = 0; j < 16; ++j) { const int c0 = 4 * (lane + 64 * j);
            const f32x4 gg = *(const f32x4*)(g + c0), sh = *(const f32x4*)(md + c0), scl = *(const f32x4*)(md + DM + c0);
            const f32x4 a = gg * (scl + 1.0f);
            const f32x4 h0 = v[j] * rs0 * a + sh, h1 = u[j] * rs1 * a + sh;
            u32x2 w0, w1; w0.x = cvt_pk_bf16(h0.x, h0.y); w0.y = cvt_pk_bf16(h0.z, h0.w); w1.x = cvt_pk_bf16(h1.x, h1.y); w1.y = cvt_pk_bf16(h1.z, h1.w);
            o8[64 * j] = w0; o8[64 * j + DM / 4] = w1; }
    }
}
constexpr int NA_VROW = 976;
__device__ __forceinline__ bool na_decode(const Frame& F, int it, int& band, int& n, int& h) {
    int idx, x;
    if (F.G == 256) { x = F.vcu >> 5; idx = it * 32 + (F.vcu & 31); if (it >= 12) return false; h = 2 * x + (idx & 1); n = (idx >> 1) & 3; band = idx >> 3; return true; }
    const int gid = F.vcu + F.G * it; if (gid >= 48 * 4 * 16) return false; h = gid & 15; n = (gid >> 4) & 3; band = gid >> 6; return true;
}
__device__ __forceinline__ void na_bandinfo(int band, int& seqbase, int& rows, int& r0, int& kr0) {
    if (band < 16) { seqbase = (band >> 2) * LP; rows = 32; r0 = (band & 3) * 8; } else { seqbase = MP; rows = 256; r0 = (band - 16) * 8; }
    kr0 = r0 - 4; kr0 = kr0 < 0 ? 0 : kr0; kr0 = kr0 > rows - 8 ? rows - 8 : kr0;
}
__device__ __forceinline__ void t3a_na(Frame& F) {
    const bf16_t* QNA = (const bf16_t*)(F.ws + WS_QNA); const bf16_t* KNA = (const bf16_t*)(F.ws + WS_KNA); const bf16_t* VT = (const bf16_t*)(F.ws + WS_VT);
    bf16_t* ONA = (bf16_t*)(F.ws + WS_ONA); const float* rpb = F.in[9];
    const int w = F.wave;
    int tid = F.tid;
#define NA_LANE_STATE() asm volatile("" : "+v"(tid)); const int lane = tid & 63, g = lane >> 4, ql = lane & 15; \
    const int kwr = (tid >> 4) * 256 + (((tid & 15) ^ ((tid >> 4) & 15)) << 4);        \
    const int vwr = (tid >> 2) * NA_VROW + (tid & 3) * 16;
    LAS float* btab = (LAS float*)(F.lds + 136192);
    int band, n, h, seqbase, rows, r0, kr0;
    bool have = na_decode(F, 0, band, n, h);
    u32x4 kst[15], vst[15];
    if (have) { na_bandinfo(band, seqbase, rows, r0, kr0);
        const int kstart = (n == 0) ? 0 : (n == 1 ? 8 : (n == 2 ? 24 : 32));
#pragma unroll
        for (int j = 0; j < 15; ++j) { int kr = kr0 + j; kr = kr > rows - 1 ? rows - 1 : kr;
            kst[j] = *(const u32x4*)(KNA + (size_t)(seqbase + kr * 64 + kstart + (tid >> 4)) * NAW + h * HD + (tid & 15) * 8); } }
    for (int it = 0; have; ++it) {
        NA_LANE_STATE();
        const int kstart = (n == 0) ? 0 : (n == 1 ? 8 : (n == 2 ? 24 : 32));
        const int r = r0 + w; int start = r - 4; start = start < 0 ? 0 : start; start = start > rows - 8 ? rows - 8 : start;
        const int wstart = start - kr0;
        const int qc = 16 * n + ql; int cstart = qc - 8; cstart = cstart < 0 ? 0 : cstart; cstart = cstart > 48 ? 48 : cstart;
#pragma unroll
        for (int j = 0; j < 15; ++j) *(LAS u32x4*)(F.lds + kwr + j * 8192) = kst[j];
        if (tid < 465) btab[tid] = rpb[h * 465 + tid] * LOG2E;
        __syncthreads();
#pragma unroll
        for (int j = 0; j < 8; ++j) { int kr = kr0 + j; kr = kr > rows - 1 ? rows - 1 : kr;
            vst[j] = *(const u32x4*)(VT + (size_t)(h * HD + (tid >> 2)) * MTOK + seqbase + kr * 64 + kstart + (tid & 3) * 8); }
        const int qtok = seqbase + r * 64 + qc;
        bf16x8 qf[4];
#pragma unroll
        for (int ds = 0; ds < 4; ++ds) qf[ds] = *(const bf16x8*)(QNA + (size_t)qtok * NAW + h * HD + ds * 32 + 8 * g);
        f32x4 s[16];
        { const int kbase = (wstart * 32 + ql) * 256;
#pragma unroll
          for (int kb = 0; kb < 16; ++kb) { const int i = kb >> 1, jh = kb & 1; f32x4 a = {0.f, 0.f, 0.f, 0.f};
#pragma unroll
            for (int ds = 0; ds < 4; ++ds) { const bf16x8 kf = *(const LAS bf16x8*)(F.lds + kbase + (i * 32 + 16 * jh) * 256 + (((ds * 4 + g) ^ ql) << 4));
                a = __builtin_amdgcn_mfma_f32_16x16x32_bf16(kf, qf[ds], a, 0, 0, 0); }
            s[kb] = a; if ((kb & 1) == 1) asm volatile("" ::: "memory"); } }
#pragma unroll
        for (int j = 8; j < 15; ++j) { int kr = kr0 + j; kr = kr > rows - 1 ? rows - 1 : kr;
            vst[j] = *(const u32x4*)(VT + (size_t)(h * HD + (tid >> 2)) * MTOK + seqbase + kr * 64 + kstart + (tid & 3) * 8); }
        float mx = -1e30f;
#pragma unroll
        for (int kb = 0; kb < 16; ++kb) { const int i = kb >> 1, jh = kb & 1; const LAS float* bp = btab + (start + i - r + 7) * 31;
#pragma unroll
            for (int t = 0; t < 4; ++t) { const int kc = kstart + 16 * jh + 4 * g + t; const bool valid = (kc >= cstart) && (kc < cstart + 16);
                int dc = kc - qc + 15; dc = dc < 0 ? 0 : (dc > 30 ? 30 : dc);
                float b = bp[dc]; asm volatile("" : "+v"(b));
                const float v = valid ? s[kb][t] + b : -1e30f; s[kb][t] = v; mx = fmaxf(mx, v); }
            if ((kb & 3) == 3) asm volatile("" ::: "memory"); }
        mx = fmaxf(mx, __shfl_xor(mx, 16)); mx = fmaxf(mx, __shfl_xor(mx, 32));
        float sum = 0.f;
#pragma unroll
        for (int kb = 0; kb < 16; ++kb)
#pragma unroll
            for (int t = 0; t < 4; ++t) { const float p = __builtin_amdgcn_exp2f(s[kb][t] - mx); s[kb][t] = p; sum += p; }
        sum += __shfl_xor(sum, 16); sum += __shfl_xor(sum, 32);
        const float rinv = 1.0f / sum;
        bf16x8 pb[8];
#pragma unroll
        for (int i = 0; i < 8; ++i) { u32x4 wv; wv.x = cvt_pk_bf16(s[2 * i][0], s[2 * i][1]); wv.y = cvt_pk_bf16(s[2 * i][2], s[2 * i][3]); wv.z = cvt_pk_bf16(s[2 * i + 1][0], s[2 * i + 1][1]); wv.w = cvt_pk_bf16(s[2 * i + 1][2], s[2 * i + 1][3]);
            pb[i] = *reinterpret_cast<bf16x8*>(&wv); }
        __syncthreads();
#pragma unroll
        for (int j = 0; j < 15; ++j) *(LAS u32x4*)(F.lds + vwr + j * 64) = vst[j];
        __syncthreads();
        const int o_qtok = qtok, o_h = h;
        have = na_decode(F, it + 1, band, n, h);
        if (have) { na_bandinfo(band, seqbase, rows, r0, kr0);
            const int kstart2 = (n == 0) ? 0 : (n == 1 ? 8 : (n == 2 ? 24 : 32));
#pragma unroll
            for (int j = 0; j < 15; ++j) { int kr = kr0 + j; kr = kr > rows - 1 ? rows - 1 : kr;
                kst[j] = *(const u32x4*)(KNA + (size_t)(seqbase + kr * 64 + kstart2 + (tid >> 4)) * NAW + h * HD + (tid & 15) * 8); } }
        bf16_t* op = ONA + (size_t)o_qtok * NAW + o_h * HD + 4 * g;
#pragma unroll
        for (int db = 0; db < 8; ++db) { f32x4 o = {0.f, 0.f, 0.f, 0.f};
            const int vb = (16 * db + ql) * NA_VROW + wstart * 64 + 8 * g;
#pragma unroll
            for (int i = 0; i < 8; ++i) { const u32x2 lo = *(const LAS u32x2*)(F.lds + vb + i * 64), hi2 = *(const LAS u32x2*)(F.lds + vb + i * 64 + 32);
                u32x4 wv; wv.x = lo.x; wv.y = lo.y; wv.z = hi2.x; wv.w = hi2.y;
                o = __builtin_amdgcn_mfma_f32_16x16x32_bf16(*reinterpret_cast<bf16x8*>(&wv), pb[i], o, 0, 0, 0); }
            u32x2 wo; wo.x = cvt_pk_bf16(o[0] * rinv, o[1] * rinv); wo.y = cvt_pk_bf16(o[2] * rinv, o[3] * rinv); *(u32x2*)(op + 16 * db) = wo;
            asm volatile("" ::: "memory"); }
        __syncthreads();
    }
#undef NA_LANE_STATE
}
__device__ __forceinline__ void t3a_phase(Frame& F) {
    const int gw = F.vcu * NWAVES + F.wave, NGW = F.G * NWAVES;
    t3a_na(F);
    const bf16_t* QD = (const bf16_t*)(F.ws + WS_QD); const bf16_t* KVD = (const bf16_t*)(F.ws + WS_KVD);
    float* rsq = (float*)(F.ws + WS_RSQ); float* rskv = (float*)(F.ws + WS_RSKV); bf16_t* KPE = (bf16_t*)(F.ws + WS_KPE);
    const float* tc = (const float*)(F.ws + WS_TBLC); const float* ts = (const float*)(F.ws + WS_TBLS);
    for (int m = gw; m < MTOK; m += NGW) {
        const u32x4* qp = (const u32x4*)(QD + (size_t)m * 1024) + 2 * F.lane;
        float sq = 0.f;
        if (F.lane < 56) { const u32x4 a = qp[0], b = qp[1]; const unsigned w[8] = {a.x, a.y, a.z, a.w, b.x, b.y, b.z, b.w};
#pragma unroll
            for (int e = 0; e < 8; ++e) { const float lo = bflo(w[e]), hi = bfhi(w[e]); sq += lo * lo + hi * hi; } }
        sq = wave_sum(sq);
        const u32x4 kv = *((const u32x4*)(KVD + (size_t)m * 512) + F.lane); float sk = 0.f;
        { const unsigned w[4] = {kv.x, kv.y, kv.z, kv.w};
#pragma unroll
          for (int e = 0; e < 4; ++e) { const float lo = bflo(w[e]), hi = bfhi(w[e]); sk += lo * lo + hi * hi; } }
        sk = wave_sum(sk);
        if (F.lane == 0) { rsq[m] = 1.0f / sqrtf(sq * (1.f / QLORA) + EPS); rskv[m] = 1.0f / sqrtf(sk * (1.f / KVLORA) + EPS); }
        if (F.lane < 32) { const int pos = pos_of(m); const float c = tc[pos * 32 + F.lane], s = ts[pos * 32 + F.lane];
            const float x1 = bf2f(QD[(size_t)m * 1024 + 896 + F.lane]), x2 = bf2f(QD[(size_t)m * 1024 + 928 + F.lane]);
            KPE[(size_t)m * 64 + F.lane] = (bf16_t)(cvt_pk_bf16(x1 * c - x2 * s, 0.f) & 0xffffu);
            KPE[(size_t)m * 64 + 32 + F.lane] = (bf16_t)(cvt_pk_bf16(x1 * s + x2 * c, 0.f) & 0xffffu); }
    }
}
__device__ __forceinline__ void t4_phase(Frame& F) {
    const bf16_t* QM = (const bf16_t*)(F.ws + WS_QM); const bf16_t* KN = (const bf16_t*)(F.ws + WS_KNOPE); const bf16_t* KPE = (const bf16_t*)(F.ws + WS_KPE);
    const bf16_t* VM = (const bf16_t*)(F.ws + WS_VM); bf16_t* OM = (bf16_t*)(F.ws + WS_OMLA);
    const float* tc = (const float*)(F.ws + WS_TBLC); const float* ts = (const float*)(F.ws + WS_TBLS);
    for (int u = F.vcu; u < 1536; u += F.G) {
        int seqbase, seq, h, qb;
        if (u < 1024) { seqbase = MP; seq = LS; h = u >> 6; qb = u & 63; }
        else { const int v = u - 1024; seqbase = (v >> 7) * LP; seq = LP; h = (v >> 3) & 15; qb = v & 7; }
        const int m0 = seqbase + qb * 256;
        mla::attn_body2(QM + (size_t)m0 * 3072 + h * DQK, KN + (size_t)seqbase * 2048 + h * HD, KPE + (size_t)seqbase * 64, VM + (size_t)seqbase * 2048 + h * HD,
                       OM + (size_t)m0 * 2048 + h * HD, seq, qb * 256, tc, ts, F.ldsg, F.wave);
    }
}
__device__ __forceinline__ void t7_norm(Frame& F) {
    const int gw = F.vcu * NWAVES + F.wave, NGW = F.G * NWAVES;
    const float* mod = (const float*)(F.ws + WS_MOD); const float* gpost = F.in[7]; const float* gpre = F.in[17];
    const bf16_t* Y1 = (const bf16_t*)(F.ws + WS_Y1); bf16_t* H = (bf16_t*)(F.ws + WS_H);
    for (int m = gw; m < MTOK; m += NGW) {
        int lane = F.lane; asm volatile("" : "+v"(lane));
        const float* xr = xrow(F, m); const float* md = mod + (size_t)seq_of(m) * NMOD; float* orow = F.out + (size_t)m * DM;
        const u32x4* yp = (const u32x4*)(Y1 + (size_t)m * DM) + lane;
        f32x4 v[16]; float s = 0.f;
#pragma unroll
        for (int j = 0; j < 8; ++j) { const u32x4 w = yp[64 * j];
            v[2 * j] = (f32x4){bflo(w.x), bfhi(w.x), bflo(w.y), bfhi(w.y)}; v[2 * j + 1] = (f32x4){bflo(w.z), bfhi(w.z), bflo(w.w), bfhi(w.w)};
            s += (v[2 * j].x * v[2 * j].x + v[2 * j].y * v[2 * j].y) + (v[2 * j].z * v[2 * j].z + v[2 * j].w * v[2 * j].w);
            s += (v[2 * j + 1].x * v[2 * j + 1].x + v[2 * j + 1].y * v[2 * j + 1].y) + (v[2 * j + 1].z * v[2 * j + 1].z + v[2 * j + 1].w * v[2 * j + 1].w); }
        const float rstd = 1.0f / sqrtf(wave_sum(s) * (1.f / DM) + EPS);
        float s2 = 0.f;
#pragma unroll
        for (int j = 0; j < 8; ++j) { const int c0 = 8 * (lane + 64 * j);
#pragma unroll
            for (int q = 0; q < 2; ++q) { const int c = c0 + 4 * q;
                const f32x4 x = *(const f32x4*)(xr + c), gg = *(const f32x4*)(gpost + c), gt = *(const f32x4*)(md + 2 * DM + c);
                const f32x4 x1 = x + gt * (v[2 * j + q] * rstd * gg);
                *(f32x4*)(orow + c) = x1; v[2 * j + q] = x1;
                s2 += (x1.x * x1.x + x1.y * x1.y) + (x1.z * x1.z + x1.w * x1.w); } }
        const float rstd2 = 1.0f / sqrtf(wave_sum(s2) * (1.f / DM) + EPS);
        u32x4* hp = (u32x4*)(H + (size_t)m * DM) + lane;
#pragma unroll
        for (int j = 0; j < 8; ++j) { const int c0 = 8 * (lane + 64 * j); f32x4 hh[2];
#pragma unroll
            for (int q = 0; q < 2; ++q) { const int c = c0 + 4 * q;
                const f32x4 gg = *(const f32x4*)(gpre + c), sh = *(const f32x4*)(md + 3 * DM + c), scl = *(const f32x4*)(md + 4 * DM + c);
                hh[q] = v[2 * j + q] * rstd2 * gg * (scl + 1.0f) + sh; }
            hp[64 * j] = pg8::pack8(hh[0], hh[1]); }
    }
}
__device__ __forceinline__ void t9_fixup(Frame& F) {
    const int gt = F.vcu * 512 + F.tid, NT = F.G * 512;
    bf16_t* G = (bf16_t*)(F.ws + WS_G); const float* side = (const float*)(F.ws + WS_SIDE); const float* cw = F.in[20];
    constexpr int SN = pg8::SIDE_N;
    for (int idx = gt; idx < 96 * (DFF / 4); idx += NT) {
        const int pm = idx / (DFF / 4), f = (idx % (DFF / 4)) * 4;
        const bool seq_start = (pm <= 32) && ((pm & 7) == 0), seq_end = (pm < 32 && (pm & 7) == 7) || pm == 95;
        const size_t o = (size_t)pm * DFF + f;
        { f32x4 pre = *(const f32x4*)(side + o); const f32x4 uu = *(const f32x4*)(side + 4 * SN + o);
          if (!seq_start) { const f32x4 al = *(const f32x4*)(side + 3 * SN + o - DFF), w = *(const f32x4*)(cw + f); pre = pre + w * al; }
          u32x2 w2; w2.x = cvt_pk_bf16(pg8::gelu_tanh_f(pre.x) * uu.x, pg8::gelu_tanh_f(pre.y) * uu.y); w2.y = cvt_pk_bf16(pg8::gelu_tanh_f(pre.z) * uu.z, pg8::gelu_tanh_f(pre.w) * uu.w);
          *(u32x2*)(G + (size_t)(pm * 256) * DFF + f) = w2; }
        { f32x4 pre = *(const f32x4*)(side + SN + o); const f32x4 uu = *(const f32x4*)(side + 5 * SN + o);
          if (!seq_end) { const f32x4 af = *(const f32x4*)(side + 2 * SN + o + DFF), w = *(const f32x4*)(cw + 2 * DFF + f); pre = pre + w * af; }
          u32x2 w2; w2.x = cvt_pk_bf16(pg8::gelu_tanh_f(pre.x) * uu.x, pg8::gelu_tanh_f(pre.y) * uu.y); w2.y = cvt_pk_bf16(pg8::gelu_tanh_f(pre.z) * uu.z, pg8::gelu_tanh_f(pre.w) * uu.w);
          *(u32x2*)(G + (size_t)(pm * 256 + 255) * DFF + f) = w2; }
    }
}
__device__ __forceinline__ void t11_final(Frame& F) {
    const int gw = F.vcu * NWAVES + F.wave, NGW = F.G * NWAVES;
    const float* mod = (const float*)(F.ws + WS_MOD); const float* gpost = F.in[18]; const bf16_t* Fb = (const bf16_t*)(F.ws + WS_F);
    for (int mp = gw; mp < MTOK / 2; mp += NGW) {
        int lane = F.lane; asm volatile("" : "+v"(lane));
        const int m = 2 * mp;
        const float* md = mod + (size_t)seq_of(m) * NMOD; float* orow = F.out + (size_t)m * DM;
        const u32x4* yp = (const u32x4*)(Fb + (size_t)m * DM) + lane;
        f32x4 v[2][16]; float s[2] = {0.f, 0.f};
#pragma unroll
        for (int rr = 0; rr < 2; ++rr)
#pragma unroll
            for (int j = 0; j < 8; ++j) { const u32x4 w = yp[64 * j + rr * (DM / 8)];
                v[rr][2 * j] = (f32x4){bflo(w.x), bfhi(w.x), bflo(w.y), bfhi(w.y)}; v[rr][2 * j + 1] = (f32x4){bflo(w.z), bfhi(w.z), bflo(w.w), bfhi(w.w)};
                const f32x4 a = v[rr][2 * j], b = v[rr][2 * j + 1];
                s[rr] += ((a.x * a.x + a.y * a.y) + (a.z * a.z + a.w * a.w)) + ((b.x * b.x + b.y * b.y) + (b.z * b.z + b.w * b.w)); }
        const float rstd[2] = {1.0f / sqrtf(wave_sum(s[0]) * (1.f / DM) + EPS), 1.0f / sqrtf(wave_sum(s[1]) * (1.f / DM) + EPS)};
#pragma unroll
        for (int j = 0; j < 8; ++j) { const int c0 = 8 * (lane + 64 * j);
#pragma unroll
            for (int q = 0; q < 2; ++q) { const int c = c0 + 4 * q;
                const f32x4 gg = *(const f32x4*)(gpost + c), gt = *(const f32x4*)(md + 5 * DM + c); const f32x4 a = gt * gg;
#pragma unroll
                for (int rr = 0; rr < 2; ++rr) { const f32x4 x1 = *(const f32x4*)(orow + rr * DM + c);
                    *(f32x4*)(orow + rr * DM + c) = x1 + a * (v[rr][2 * j + q] * rstd[rr]); } } }
    }
}

constexpr int NPHASE = 13;
struct Args { const float* in[23]; float* out; unsigned char* ws; int ph_lo, ph_hi; };
__global__ void __launch_bounds__(NWAVES * 64, 2) fwd_kernel(Args args) {
    extern __shared__ __attribute__((aligned(16))) unsigned char lds[];
    Frame F;
    F.lds = (LAS unsigned char*)lds; F.ldsg = (char*)lds;
    F.MISC = (volatile LAS unsigned*)(F.lds + MISC_OFF);
    F.tid = threadIdx.x; F.lane = F.tid & 63; F.wave = __builtin_amdgcn_readfirstlane(F.tid >> 6);
    F.G = gridDim.x; { const int bx = blockIdx.x; F.vcu = (F.G % 8 == 0) ? (bx % 8) * (F.G / 8) + bx / 8 : bx; }
#pragma unroll
    for (int i = 0; i < 23; ++i) F.in[i] = args.in[i];
    F.out = args.out; F.ws = args.ws; F.ctl = (unsigned*)(args.ws + WS_CTL);
    for (int u = F.tid; u < (LDS_BYTES - LDSCTL_OFF) / 4; u += NWAVES * 64) ((LAS unsigned*)(F.lds + LDSCTL_OFF))[u] = 0u;
    __syncthreads();
    XcdBarrier bar; bar.bar = F.ctl + CW_BAR; bar.x = 0; bar.st = nullptr; bar.wave = 0;
    if (MK_N_LAUNCHES == 1) bar = xcd_barrier_post(F.ctl + CW_BAR, F.MISC + 8, F.wave);
    const int lo = args.ph_lo, hi = args.ph_hi;
#ifndef PHASE_MASK
#define PHASE_MASK 0xffff
#endif
#define IN(k) (((PHASE_MASK >> (k)) & 1) && lo <= (k) && (k) < hi)
#ifndef DUP_MASK
#define DUP_MASK 0
#endif
#define FRESH() do { F.lane = fresh_lane(); F.tid = F.wave * 64 + F.lane; } while (0)
#define REP(k) for (int rep_ = 0; rep_ < (((DUP_MASK >> (k)) & 1) ? 2 : 1); ++rep_)
#define SEAM(k) do { if (IN(k) && IN((k) + 1)) xcd_barrier(bar); } while (0)
    unsigned char* ws = F.ws;
    const int bx = (int)blockIdx.x;

    if (IN(0)) REP(0) { FRESH(); p0_mod(F); p0_weights(F); p0_tables(F); }
    SEAM(0);
    if (IN(1)) REP(1) { FRESH(); t1_norm(F); }
    SEAM(1);
    if (IN(2)) REP(2) { FRESH();
        { pg8::Gemm g{(const bf16_t*)(ws + WS_H), (const bf16_t*)(ws + WS_BIN), MTOK, ZN1, DM, DM, DM}; pg8::StaticOrder S; S.init(MTOK, ZN1, F.G, bx);
          pg8::EpiZ E{(bf16_t*)(ws + WS_QNA), (bf16_t*)(ws + WS_KNA), (bf16_t*)(ws + WS_QD), (bf16_t*)(ws + WS_KVD), (bf16_t*)F.out, (bf16_t*)F.out + (size_t)MTOK * DM};
          pg8::gemm_phase<pg8::EpiZ, pg8::StaticOrder>(F.lds, g, S, E, F.wave); }
        { pg8::Gemm g{(const bf16_t*)(ws + WS_BIN) + (size_t)ZN1 * DM, (const bf16_t*)(ws + WS_H), NAW, MTOK, DM, DM, DM}; pg8::StaticOrder S; S.init(NAW, MTOK, F.G, bx);
          pg8::EpiPlain E{(bf16_t*)(ws + WS_VT), MTOK};
          pg8::gemm_phase<pg8::EpiPlain, pg8::StaticOrder>(F.lds, g, S, E, F.wave); }
    }
    SEAM(2);
    if (IN(3)) REP(3) { FRESH(); t3a_phase(F); }
    SEAM(3);
    if (IN(4)) REP(4) { FRESH();
        { pg8::Gemm g{(const bf16_t*)(ws + WS_QD), (const bf16_t*)(ws + WS_BUQ), MTOK, 3072, QLORA, 1024, QLORA}; pg8::StaticOrder S; S.init(MTOK, 3072, F.G, bx);
          pg8::EpiUQ E{(bf16_t*)(ws + WS_QM), (const float*)(ws + WS_RSQ)};
          pg8::gemm_phase<pg8::EpiUQ, pg8::StaticOrder>(F.lds, g, S, E, F.wave); }
        { pg8::Gemm g{(const bf16_t*)(ws + WS_KVD), (const bf16_t*)(ws + WS_BUKV), MTOK, 4096, KVLORA, KVLORA, KVLORA}; pg8::StaticOrder S; S.init(MTOK, 4096, F.G, bx);
          pg8::EpiUKV E{(bf16_t*)(ws + WS_KNOPE), (bf16_t*)(ws + WS_VM), (const float*)(ws + WS_RSKV)};
          pg8::gemm_phase<pg8::EpiUKV, pg8::StaticOrder>(F.lds, g, S, E, F.wave); }
    }
    SEAM(4);
    if (IN(5)) REP(5) { FRESH(); t4_phase(F); }
    SEAM(5);
    if (IN(6)) REP(6) { FRESH();
        { pg8::Gemm g{(const bf16_t*)(ws + WS_ONA), (const bf16_t*)(ws + WS_BNA), MTOK, DM, NAW, NAW, NAW, (const bf16_t*)(ws + WS_OMLA), (const bf16_t*)(ws + WS_BMLA)}; pg8::DualOrder S; S.init(MTOK, DM, F.G, bx);
          pg8::EpiMergeDual E{(bf16_t*)(ws + WS_T), (const bf16_t*)F.out, (const bf16_t*)F.out + (size_t)MTOK * DM};
          pg8::gemm_phase<pg8::EpiMergeDual, pg8::DualOrder>(F.lds, g, S, E, F.wave); }
    }
    SEAM(6);
    if (IN(7)) REP(7) { FRESH();
        pg8::Gemm g{(const bf16_t*)(ws + WS_T), (const bf16_t*)(ws + WS_BOUT), MTOK, DM, DM, DM, DM}; pg8::StaticOrder S; S.init(MTOK, DM, F.G, bx);
        pg8::EpiPlain E{(bf16_t*)(ws + WS_Y1), DM};
        pg8::gemm_phase<pg8::EpiPlain, pg8::StaticOrder>(F.lds, g, S, E, F.wave);
    }
    SEAM(7);
    if (IN(8)) REP(8) { FRESH(); t7_norm(F); }
    SEAM(8);
    if (IN(9)) REP(9) { FRESH();
        pg8::Gemm g{(const bf16_t*)(ws + WS_H), (const bf16_t*)(ws + WS_BFFN), MTOK, 2 * DFF, DM, DM, DM}; pg8::StaticOrder S; S.init(MTOK, 2 * DFF, F.G, bx);
        pg8::EpiFFNConv E{(bf16_t*)(ws + WS_G), (float*)(ws + WS_SIDE), F.in[20], F.in[21], (LAS float*)(F.lds + RING_BYTES)};
        pg8::gemm_phase<pg8::EpiFFNConv, pg8::StaticOrder>(F.lds, g, S, E, F.wave);
    }
    SEAM(9);
    if (IN(10)) REP(10) { FRESH(); t9_fixup(F); }
    SEAM(10);
    if (IN(11)) REP(11) { FRESH();
        pg8::Gemm g{(const bf16_t*)(ws + WS_G), (const bf16_t*)(ws + WS_BDOWN), MTOK, DM, DFF, DFF, DFF}; pg8::StaticOrder S; S.init(MTOK, DM, F.G, bx);
        pg8::EpiPlain E{(bf16_t*)(ws + WS_F), DM};
        pg8::gemm_phase<pg8::EpiPlain, pg8::StaticOrder>(F.lds, g, S, E, F.wave);
    }
    SEAM(11);
    if (IN(12)) REP(12) { FRESH(); t11_final(F); }
#undef IN
#undef SEAM
}

extern "C" void kernel_launch(void* const* d_in, const int* in_sizes, int n_in, void* d_out, int out_size, void* d_ws, size_t ws_size, hipStream_t stream) {
    static int grid = 0;
    if (grid == 0) {
        if (n_in != 23 || out_size != MTOK * DM || ws_size < WS_END) { fprintf(stderr, "kernel_launch: unexpected shapes (n_in %d, out %d, ws %zu; need ws >= %zu)\n", n_in, out_size, ws_size, (size_t)WS_END); grid = -1; return; }
        int dev = 0, cus = 0, per_cu = 0;
        if (hipGetDevice(&dev) != hipSuccess || hipDeviceGetAttribute(&cus, hipDeviceAttributeMultiprocessorCount, dev) != hipSuccess) { grid = -1; return; }
        if (hipFuncSetAttribute((const void*)fwd_kernel, hipFuncAttributeMaxDynamicSharedMemorySize, LDS_BYTES) != hipSuccess) { fprintf(stderr, "kernel_launch: hipFuncSetAttribute failed\n"); grid = -1; return; }
        if (hipOccupancyMaxActiveBlocksPerMultiprocessor(&per_cu, (const void*)fwd_kernel, NWAVES * 64, LDS_BYTES) != hipSuccess || per_cu < 1) { fprintf(stderr, "kernel_launch: occupancy query says %d blocks per CU\n", per_cu); }
        (void)hipGetLastError();
        grid = cus;
    }
    if (grid < 0) return;
    (void)hipMemsetAsync((char*)d_ws + WS_CTL, 0, CTL_ZERO_BYTES, stream);
    Args a{};
    for (int i = 0; i < 23; ++i) a.in[i] = (const float*)d_in[i];
    a.out = (float*)d_out; a.ws = (unsigned char*)d_ws;
    if (MK_N_LAUNCHES == 1) { a.ph_lo = 0; a.ph_hi = NPHASE; hipLaunchKernelGGL(fwd_kernel, dim3(grid), dim3(NWAVES * 64), LDS_BYTES, stream, a); }
    else { for (int p = 0; p < NPHASE; ++p) { a.ph_lo = p; a.ph_hi = p + 1; hipLaunchKernelGGL(fwd_kernel, dim3(grid), dim3(NWAVES * 64), LDS_BYTES, stream, a); } }
    const hipError_t le = hipPeekAtLastError();
    if (le != hipSuccess) fprintf(stderr, "kernel_launch: launch failed: %s\n", hipGetErrorName(le));
}
```
